# Optimizing an MI355X kernel written in HIP

```python
import math
import jax, jax.numpy as jnp
from jax import lax
import numpy as np

D_MODEL = 1024
BATCH = 8
SEQ = 4096
DEPTH = 2
DEC_BATCH = 8
DEC_SEQ = 2048
PAST_LEN = 128

N_MEM = 256
D_FF = 4 * D_MODEL
CROSS_HEADS = 4
CROSS_HEAD_DIM = D_MODEL // CROSS_HEADS
S5_WIDTH = D_MODEL // 2
S5_GROUP = 16
S5_GROUPS = S5_WIDTH // S5_GROUP
S5_STATE = 64
SGU_WIDTH = D_MODEL // 2
SGU_HEADS = 4
SGU_HEAD_DIM = SGU_WIDTH // SGU_HEADS
SGU_CHUNK = 128
AB_IN = S5_WIDTH + 2 * SGU_WIDTH
AB_OUT = S5_WIDTH + SGU_WIDTH
POOL_WINDOWS = (2, 4, 8, 16)
POOL_GROUPS = len(POOL_WINDOWS)
POOL_GROUP_DIM = D_MODEL // POOL_GROUPS
N_EVEN = (DEPTH + 1) // 2
N_ODD = DEPTH // 2
EPS = 1e-6

kernel_name = "hybrid_s5_sgu_pool_macaron_encoder"


def _rmsnorm(x, g):
    xf = x.astype(jnp.float32)
    y = xf * lax.rsqrt(jnp.mean(xf * xf, axis=-1, keepdims=True) + EPS)
    return (y * g.astype(jnp.float32)).astype(x.dtype)


def _layernorm(x, g, b):
    xf = x.astype(jnp.float32)
    mu = jnp.mean(xf, axis=-1, keepdims=True)
    xc = xf - mu
    var = jnp.mean(xc * xc, axis=-1, keepdims=True)
    y = xc * lax.rsqrt(var + EPS) * g.astype(jnp.float32) + b.astype(jnp.float32)
    return y.astype(x.dtype)


def _swiglu(h, w_gate, w_up, w_down):
    return (jax.nn.silu(h @ w_gate) * (h @ w_up)) @ w_down


def _complex_linear_combine(left, right):
    a1r, a1i, b1r, b1i = left
    a2r, a2i, b2r, b2i = right
    ar = a2r * a1r - a2i * a1i
    ai = a2r * a1i + a2i * a1r
    br = a2r * b1r - a2i * b1i + b2r
    bi = a2r * b1i + a2i * b1r + b2i
    return (ar, ai, br, bi)


def _s5_direction(uf, lam_re, lam_im, log_dt, b_re, b_im, c_re, c_im, reverse):
    L = uf.shape[1]
    dt = jnp.exp(log_dt)[:, None]
    mag = jnp.exp(lam_re * dt)
    ang = lam_im * dt
    ab_re = mag * jnp.cos(ang)
    ab_im = mag * jnp.sin(ang)
    nr = ab_re - 1.0
    ni = ab_im
    den = lam_re * lam_re + lam_im * lam_im
    q_re = (nr * lam_re + ni * lam_im) / den
    q_im = (ni * lam_re - nr * lam_im) / den
    bb_re = q_re[..., None] * b_re - q_im[..., None] * b_im
    bb_im = q_re[..., None] * b_im + q_im[..., None] * b_re
    x_re = jnp.einsum('blgc,gpc->blgp', uf, bb_re)
    x_im = jnp.einsum('blgc,gpc->blgp', uf, bb_im)
    a_shape = (1, L) + ab_re.shape
    a_re = jnp.broadcast_to(ab_re, a_shape)
    a_im = jnp.broadcast_to(ab_im, a_shape)
    _, _, h_re, h_im = lax.associative_scan(
        _complex_linear_combine, (a_re, a_im, x_re, x_im), reverse=reverse, axis=1)
    return (jnp.einsum('blgp,gcp->blgc', h_re, c_re)
            - jnp.einsum('blgp,gcp->blgc', h_im, c_im))


def _s5_mixer(u, lam_re, lam_im, log_dt, b_re, b_im, c_re, c_im, d, w_glu):
    f32 = jnp.float32
    Bn, L, W = u.shape
    uf = u.astype(f32)
    ug = uf.reshape(Bn, L, S5_GROUPS, S5_GROUP)
    y_fwd = _s5_direction(ug, lam_re[0].astype(f32), lam_im[0].astype(f32), log_dt[0].astype(f32),
                          b_re[0].astype(f32), b_im[0].astype(f32),
                          c_re[0].astype(f32), c_im[0].astype(f32), False)
    y_bwd = _s5_direction(ug, lam_re[1].astype(f32), lam_im[1].astype(f32), log_dt[1].astype(f32),
                          b_re[1].astype(f32), b_im[1].astype(f32),
                          c_re[1].astype(f32), c_im[1].astype(f32), True)
    y = (y_fwd + y_bwd).reshape(Bn, L, W) + d.astype(f32) * uf
    g = jax.nn.gelu(y).astype(u.dtype)
    return g * jax.nn.sigmoid(g @ w_glu)


def _sgu_mixer(u, v, norm_g, norm_b, w_s, b_s):
    Bn, L, W = u.shape
    u = jax.nn.gelu(u)
    v = _layernorm(jax.nn.gelu(v), norm_g, norm_b)
    vc = v.reshape(Bn, L // SGU_CHUNK, SGU_CHUNK, SGU_HEADS, SGU_HEAD_DIM)
    vs = jnp.einsum('bnjhd,hij->bnihd', vc, w_s) + b_s.T[:, :, None]
    return u * vs.reshape(Bn, L, W)


def _pool_mixer(h, pool_w, pool_scale):
    f32 = jnp.float32
    Bn, L, D = h.shape
    hf = h.astype(f32)
    cs = jnp.concatenate([jnp.zeros((Bn, 1, D), f32), jnp.cumsum(hf, axis=1)], axis=1)
    t = jnp.arange(L)
    outs = []
    for gi, w in enumerate(POOL_WINDOWS):
        lo = jnp.clip(t - w // 2, 0, L)
        hi = jnp.clip(t + w // 2, 0, L)
        csg = cs[..., gi * POOL_GROUP_DIM:(gi + 1) * POOL_GROUP_DIM]
        s = jnp.take(csg, hi, axis=1) - jnp.take(csg, lo, axis=1)
        cnt = (hi - lo).astype(f32)[None, :, None]
        pooled = s / cnt - hf[..., gi * POOL_GROUP_DIM:(gi + 1) * POOL_GROUP_DIM]
        outs.append(jnp.einsum('bld,de->ble', pooled, pool_w[gi].astype(f32)))
    y = jnp.concatenate(outs, axis=-1) * pool_scale.astype(f32)
    return y.astype(h.dtype)


def _cross_attn(h, m, w_q, w_kv, w_o):
    Bn, L, D = h.shape
    M = m.shape[1]
    q = (h @ w_q).reshape(Bn, L, CROSS_HEADS, CROSS_HEAD_DIM)
    kv = m @ w_kv
    k = kv[..., :D].reshape(Bn, M, CROSS_HEADS, CROSS_HEAD_DIM)
    v = kv[..., D:].reshape(Bn, M, CROSS_HEADS, CROSS_HEAD_DIM)
    s = jnp.einsum('blhd,bmhd->bhlm', q, k).astype(jnp.float32) * (CROSS_HEAD_DIM ** -0.5)
    p = jax.nn.softmax(s, axis=-1).astype(h.dtype)
    o = jnp.einsum('bhlm,bmhd->blhd', p, v).reshape(Bn, L, D)
    return o @ w_o


def _trunk(x, mem, p):
    for i in range(DEPTH):
        h = _rmsnorm(x, p['ffn1_norm'][i])
        x = x + 0.5 * _swiglu(h, p['ffn1_w_gate'][i], p['ffn1_w_up'][i], p['ffn1_w_down'][i])
        h = _rmsnorm(x, p['mix_norm'][i])
        if i % 2 == 0:
            e = i // 2
            z = h @ p['ab_w_in'][e]
            ua = z[..., :S5_WIDTH]
            ub = z[..., S5_WIDTH:S5_WIDTH + SGU_WIDTH]
            vb = z[..., S5_WIDTH + SGU_WIDTH:]
            ya = _s5_mixer(ua, p['s5_lambda_re'][e], p['s5_lambda_im'][e], p['s5_log_dt'][e],
                           p['s5_b_re'][e], p['s5_b_im'][e], p['s5_c_re'][e], p['s5_c_im'][e],
                           p['s5_d'][e], p['s5_w_glu'][e])
            yb = _sgu_mixer(ub, vb, p['sgu_norm_g'][e], p['sgu_norm_b'][e],
                            p['sgu_w_s'][e], p['sgu_b_s'][e])
            x = x + jnp.concatenate([ya, yb], axis=-1) @ p['ab_w_out'][e]
        else:
            o = i // 2
            x = x + _pool_mixer(h, p['pool_w'][o], p['pool_scale'][o])
        hm = _rmsnorm(mem, p['mem_norm'][i])
        h = _rmsnorm(x, p['cross_norm'][i])
        x = x + _cross_attn(h, hm, p['cross_w_q'][i], p['cross_w_kv'][i], p['cross_w_o'][i])
        h = _rmsnorm(x, p['ffn2_norm'][i])
        x = x + 0.5 * _swiglu(h, p['ffn2_w_gate'][i], p['ffn2_w_up'][i], p['ffn2_w_down'][i])
    return _rmsnorm(x, p['final_norm'])


def setup_inputs(seed: int = 0) -> dict:
    key = jax.random.key(seed)
    keys = iter(jax.random.split(key, 48))
    f32 = jnp.float32

    def nrm(shape, scale):
        return jax.random.normal(next(keys), shape, f32) * scale

    def gain(shape):
        return 1.0 + 0.01 * jax.random.normal(next(keys), shape, f32)

    D, F, G, P, C = D_MODEL, D_FF, S5_GROUPS, S5_STATE, S5_GROUP
    inp = {}
    inp['x_prompt'] = nrm((BATCH, SEQ, D), 1.0)
    inp['x_sample'] = nrm((DEC_BATCH, DEC_SEQ, D), 1.0)
    inp['mem_prompt'] = nrm((BATCH, N_MEM, D), 1.0)
    inp['mem_sample'] = nrm((DEC_BATCH, N_MEM, D), 1.0)
    inp['ffn1_norm'] = gain((DEPTH, D))
    inp['ffn1_w_gate'] = nrm((DEPTH, D, F), D ** -0.5)
    inp['ffn1_w_up'] = nrm((DEPTH, D, F), D ** -0.5)
    inp['ffn1_w_down'] = nrm((DEPTH, F, D), F ** -0.5)
    inp['mix_norm'] = gain((DEPTH, D))
    inp['ab_w_in'] = nrm((N_EVEN, D, AB_IN), D ** -0.5)
    inp['s5_lambda_re'] = -0.5 + 0.01 * jax.random.normal(next(keys), (N_EVEN, 2, G, P), f32)
    inp['s5_lambda_im'] = (np.pi * jnp.arange(P, dtype=f32)
                           + 0.01 * jax.random.normal(next(keys), (N_EVEN, 2, G, P), f32))
    inp['s5_log_dt'] = jax.random.uniform(next(keys), (N_EVEN, 2, G), f32,
                                          minval=math.log(1e-3), maxval=math.log(1e-1))
    inp['s5_b_re'] = nrm((N_EVEN, 2, G, P, C), (2 * C) ** -0.5)
    inp['s5_b_im'] = nrm((N_EVEN, 2, G, P, C), (2 * C) ** -0.5)
    inp['s5_c_re'] = nrm((N_EVEN, 2, G, C, P), P ** -0.5)
    inp['s5_c_im'] = nrm((N_EVEN, 2, G, C, P), P ** -0.5)
    inp['s5_d'] = nrm((N_EVEN, S5_WIDTH), 1.0)
    inp['s5_w_glu'] = nrm((N_EVEN, S5_WIDTH, S5_WIDTH), S5_WIDTH ** -0.5)
    inp['sgu_norm_g'] = gain((N_EVEN, SGU_WIDTH))
    inp['sgu_norm_b'] = nrm((N_EVEN, SGU_WIDTH), 0.01)
    inp['sgu_w_s'] = nrm((N_EVEN, SGU_HEADS, SGU_CHUNK, SGU_CHUNK), SGU_CHUNK ** -0.5)
    inp['sgu_b_s'] = gain((N_EVEN, SGU_HEADS, SGU_CHUNK))
    inp['ab_w_out'] = nrm((N_EVEN, AB_OUT, D), AB_OUT ** -0.5)
    inp['pool_w'] = nrm((N_ODD, POOL_GROUPS, POOL_GROUP_DIM, POOL_GROUP_DIM), POOL_GROUP_DIM ** -0.5)
    inp['pool_scale'] = gain((N_ODD, D))
    inp['cross_norm'] = gain((DEPTH, D))
    inp['mem_norm'] = gain((DEPTH, D))
    inp['cross_w_q'] = nrm((DEPTH, D, D), D ** -0.5)
    inp['cross_w_kv'] = nrm((DEPTH, D, 2 * D), D ** -0.5)
    inp['cross_w_o'] = nrm((DEPTH, D, D), D ** -0.5)
    inp['ffn2_norm'] = gain((DEPTH, D))
    inp['ffn2_w_gate'] = nrm((DEPTH, D, F), D ** -0.5)
    inp['ffn2_w_up'] = nrm((DEPTH, D, F), D ** -0.5)
    inp['ffn2_w_down'] = nrm((DEPTH, F, D), F ** -0.5)
    inp['final_norm'] = gain((D,))
    return inp


def reference(x_prompt, x_sample, mem_prompt, mem_sample,
              ffn1_norm, ffn1_w_gate, ffn1_w_up, ffn1_w_down,
              mix_norm, ab_w_in,
              s5_lambda_re, s5_lambda_im, s5_log_dt, s5_b_re, s5_b_im, s5_c_re, s5_c_im,
              s5_d, s5_w_glu,
              sgu_norm_g, sgu_norm_b, sgu_w_s, sgu_b_s, ab_w_out,
              pool_w, pool_scale,
              cross_norm, mem_norm, cross_w_q, cross_w_kv, cross_w_o,
              ffn2_norm, ffn2_w_gate, ffn2_w_up, ffn2_w_down,
              final_norm):
    p = dict(ffn1_norm=ffn1_norm, ffn1_w_gate=ffn1_w_gate, ffn1_w_up=ffn1_w_up,
             ffn1_w_down=ffn1_w_down, mix_norm=mix_norm, ab_w_in=ab_w_in,
             s5_lambda_re=s5_lambda_re, s5_lambda_im=s5_lambda_im, s5_log_dt=s5_log_dt,
             s5_b_re=s5_b_re, s5_b_im=s5_b_im, s5_c_re=s5_c_re, s5_c_im=s5_c_im,
             s5_d=s5_d, s5_w_glu=s5_w_glu,
             sgu_norm_g=sgu_norm_g, sgu_norm_b=sgu_norm_b, sgu_w_s=sgu_w_s, sgu_b_s=sgu_b_s,
             ab_w_out=ab_w_out, pool_w=pool_w, pool_scale=pool_scale,
             cross_norm=cross_norm, mem_norm=mem_norm, cross_w_q=cross_w_q,
             cross_w_kv=cross_w_kv, cross_w_o=cross_w_o,
             ffn2_norm=ffn2_norm, ffn2_w_gate=ffn2_w_gate, ffn2_w_up=ffn2_w_up,
             ffn2_w_down=ffn2_w_down, final_norm=final_norm)
    y_prompt = _trunk(x_prompt, mem_prompt, p)
    y_sample = _trunk(x_sample, mem_sample, p)
    return (y_prompt, y_sample)
```

```cpp
#include <hip/hip_runtime.h>
#include <hip/hip_cooperative_groups.h>
#include <cstdio>
#include <cstdint>
namespace cg = cooperative_groups;

__device__ __forceinline__ int opq(int v) { asm volatile("" : "+v"(v)); return v; }

namespace pg8 {
#define PG8_LAS __attribute__((address_space(3)))
typedef unsigned short bf16_t;
typedef short bf16x8 __attribute__((ext_vector_type(8)));
typedef float f32x4 __attribute__((ext_vector_type(4)));
typedef float f32x2 __attribute__((ext_vector_type(2)));
typedef unsigned u32x4 __attribute__((ext_vector_type(4)));
typedef unsigned u32x2 __attribute__((ext_vector_type(2)));
constexpr int BM = 256, BK = 64, HALF = 128, HTB = HALF * BK * 2  , STAGE_BYTES = 8 * HTB, NXCD = 8, WGM = 8;

__host__ __device__ __forceinline__ int lds_byte(int r, int c) { const int st = (r >> 4) * 2 + (c >> 5), rr = r & 15, cc = c & 31, ob = rr * 64 + cc * 2; return st * 1024 + (ob ^ (((ob >> 9) & 1) << 5)); }
__host__ __device__ __forceinline__ void stage_rc(int b, int& R, int& C) { const int st = b / 1024, sb = b % 1024, swz = sb ^ (((sb >> 9) & 1) << 5); R = (st >> 1) * 16 + swz / 64; C = (st & 1) * 32 + (swz % 64) / 2; }
__host__ __device__ __forceinline__ int perm32(int rho) { const int n = rho >> 4, i = rho & 15; return 8 * (i >> 2) + 4 * n + (i & 3); }

struct Unit { int pm, pn, g; };
struct Gemm { const bf16_t* A; const bf16_t* Bt; int lda, ldb, K; size_t a_pm, a_pn, a_g, b_pn, b_g; const bf16_t* A2; int pm2; };

struct Order {
    int nM, nN, nwg, tot, G, c;
    __device__ __forceinline__ void init(int nM_, int nN_, int nG_, int G_, int c_) { nM = nM_; nN = nN_; nwg = nM_ * nN_; tot = nwg * nG_; G = G_; c = c_; }
    __device__ __forceinline__ bool next(int i, Unit& u) const {
        const int L = i * G + c; if (L >= tot) return false;
        if (tot == nwg) {
            int wgid = L; { const int q = nwg / NXCD, r = nwg % NXCD, xcd = wgid % NXCD, off = wgid / NXCD; wgid = (xcd < r ? xcd * (q + 1) : r * (q + 1) + (xcd - r) * q) + off; }
            const int nig = WGM * nN, gid = wgid / nig, fm = gid * WGM, gsz = (nM - fm) < WGM ? (nM - fm) : WGM;
            u.pm = fm + ((wgid % nig) % gsz); u.pn = (wgid % nig) / gsz; u.g = 0;
        } else { u.g = L / nwg; const int r = L % nwg; u.pm = r / nN; u.pn = r % nN; }
        return true;
    }
    __device__ __forceinline__ void a_ready(const Unit&) const {}
    __device__ __forceinline__ void done(const Unit&) const {}
};

typedef __bf16 bf16x2_t __attribute__((ext_vector_type(2)));
__device__ __forceinline__ unsigned cvt_pk_bf16(float lo, float hi) { const f32x2 v = {lo, hi}; const bf16x2_t b = __builtin_convertvector(v, bf16x2_t); return __builtin_bit_cast(unsigned, b); }
__device__ __forceinline__ u32x4 pack8(const f32x4 a, const f32x4 b) { u32x4 w; w.x = cvt_pk_bf16(a[0], a[1]); w.y = cvt_pk_bf16(a[2], a[3]); w.z = cvt_pk_bf16(b[0], b[1]); w.w = cvt_pk_bf16(b[2], b[3]); return w; }
__device__ __forceinline__ float bf_lo(unsigned w) { return __uint_as_float(w << 16); }
__device__ __forceinline__ float bf_hi(unsigned w) { return __uint_as_float(w & 0xffff0000u); }
__device__ __forceinline__ float sigm(float x) { return __builtin_amdgcn_rcpf(1.0f + __builtin_amdgcn_exp2f(-1.4426950408889634f * x)); }
__device__ __forceinline__ float silu_f(float x) { return x * sigm(x); }
__device__ __forceinline__ float gelu_t(float x) { return x * sigm(1.5957691216057308f * (x + 0.044715f * x * x * x)); }
__device__ __forceinline__ f32x4 gelu4(const f32x4 x) { f32x4 t = (x * x * 0.044715f + 1.0f) * x * (-1.5957691216057308f * 1.4426950408889634f);
    _Pragma("unroll") for (int e = 0; e < 4; ++e) t[e] = __builtin_amdgcn_exp2f(t[e]);
    t += 1.0f;
    _Pragma("unroll") for (int e = 0; e < 4; ++e) t[e] = __builtin_amdgcn_rcpf(t[e]);
    return x * t; }
__device__ __forceinline__ float fq_sum(float v) {
    auto r16 = __builtin_amdgcn_permlane16_swap(__float_as_uint(v), __float_as_uint(v), false, false); v = __uint_as_float(r16[0]) + __uint_as_float(r16[1]);
    auto r32 = __builtin_amdgcn_permlane32_swap(__float_as_uint(v), __float_as_uint(v), false, false); return __uint_as_float(r32[0]) + __uint_as_float(r32[1]); }
__device__ __forceinline__ float row_rs16(const float* part, int row, int fq) {
    const f32x4 v = *(const f32x4*)(part + (size_t)row * 16 + fq * 4);
    float s = (v[0] + v[1]) + (v[2] + v[3]); s += __shfl_xor(s, 16); s += __shfl_xor(s, 32);
    return __builtin_amdgcn_rsqf(s * (1.0f / 1024.0f) + 1e-6f);
}
#define EPI_ROWS(...) _Pragma("unroll") for (int ai = 0; ai < 2; ++ai) _Pragma("unroll") for (int m = 0; m < 4; ++m) { const int row = u.pm * BM + ai * HALF + wr * 64 + m * 16 + fr; __VA_ARGS__ }

#define EPI_RS8(part_) float rsv[2][4]; { f32x4 pq_[2][4]; \
    _Pragma("unroll") for (int ai = 0; ai < 2; ++ai) _Pragma("unroll") for (int m = 0; m < 4; ++m) pq_[ai][m] = *(const f32x4*)((part_) + (size_t)(u.pm * BM + ai * HALF + wr * 64 + m * 16 + fr) * 16 + fq * 4); \
    _Pragma("unroll") for (int ai = 0; ai < 2; ++ai) _Pragma("unroll") for (int m = 0; m < 4; ++m) rsv[ai][m] = (pq_[ai][m][0] + pq_[ai][m][1]) + (pq_[ai][m][2] + pq_[ai][m][3]); \
    _Pragma("unroll") for (int ai = 0; ai < 2; ++ai) _Pragma("unroll") for (int m = 0; m < 4; ++m) rsv[ai][m] = fq_sum(rsv[ai][m]); \
    _Pragma("unroll") for (int ai = 0; ai < 2; ++ai) _Pragma("unroll") for (int m = 0; m < 4; ++m) rsv[ai][m] = __builtin_amdgcn_rsqf(rsv[ai][m] * (1.0f / 1024.0f) + 1e-6f); }
struct EpiSwiGLU {
    static constexpr bool PERM = true, AFTER_DRAIN = false;
    bf16_t* H; bf16_t* H2; const float* part;
    __device__ __forceinline__ void operator()(const f32x4 (&acc)[2][2][4][2], const Unit& u, int wr, int wc, int fr, int fq) const {
        const int col = u.pn * HALF + wc * 32 + fq * 8;
        bf16_t* hb = u.pm < 128 ? H : H2 - (size_t)32768 * 4096;
        EPI_RS8(part)
        EPI_ROWS(
            const float rs = rsv[ai][m];
            const f32x4 g0 = acc[ai][0][m][0] * rs, g1 = acc[ai][0][m][1] * rs, u0 = acc[ai][1][m][0] * rs, u1 = acc[ai][1][m][1] * rs;
            f32x4 e0 = g0 * -1.4426950408889634f, e1 = g1 * -1.4426950408889634f;
            _Pragma("unroll") for (int e = 0; e < 4; ++e) { e0[e] = __builtin_amdgcn_exp2f(e0[e]); e1[e] = __builtin_amdgcn_exp2f(e1[e]); }
            e0 += 1.0f; e1 += 1.0f;
            _Pragma("unroll") for (int e = 0; e < 4; ++e) { e0[e] = __builtin_amdgcn_rcpf(e0[e]); e1[e] = __builtin_amdgcn_rcpf(e1[e]); }
            const f32x4 h0 = (g0 * u0) * e0, h1 = (g1 * u1) * e1;
            __builtin_nontemporal_store(pack8(h0, h1), (u32x4*)(hb + (size_t)row * 4096 + col));
        )
    }
};
struct EpiRes {
    static constexpr bool PERM = true, AFTER_DRAIN = false;
    bf16_t* xb; float* part_out; float alpha;
    __device__ __forceinline__ void operator()(const f32x4 (&acc)[2][2][4][2], const Unit& u, int wr, int wc, int fr, int fq) const {
        const int col0 = u.pn * BM + wc * 32 + fq * 8;
#pragma unroll
        for (int ai = 0; ai < 2; ++ai) {
            u32x4 xv[4][2];
#pragma unroll
            for (int m = 0; m < 4; ++m)
#pragma unroll
                for (int bj = 0; bj < 2; ++bj) xv[m][bj] = *(const u32x4*)(xb + (size_t)(u.pm * BM + ai * HALF + wr * 64 + m * 16 + fr) * 1024 + col0 + bj * HALF);
#pragma unroll
            for (int m = 0; m < 4; ++m) {
                const int row = u.pm * BM + ai * HALF + wr * 64 + m * 16 + fr;
                float ss = 0.f;
#pragma unroll
                for (int bj = 0; bj < 2; ++bj) {
                    const u32x4 w = xv[m][bj];
                    f32x4 v0 = (f32x4){bf_lo(w.x), bf_hi(w.x), bf_lo(w.y), bf_hi(w.y)}; f32x4 v1 = (f32x4){bf_lo(w.z), bf_hi(w.z), bf_lo(w.w), bf_hi(w.w)};
                    v0 += acc[ai][bj][m][0] * alpha; v1 += acc[ai][bj][m][1] * alpha;
                    ss += (v0[0] * v0[0] + v0[1] * v0[1]) + (v0[2] * v0[2] + v0[3] * v0[3]) + (v1[0] * v1[0] + v1[1] * v1[1]) + (v1[2] * v1[2] + v1[3] * v1[3]);
                    *(u32x4*)(xb + (size_t)row * 1024 + col0 + bj * HALF) = pack8(v0, v1);
                }
                ss = fq_sum(ss);
                if (fq == 0) part_out[(size_t)row * 16 + u.pn * 4 + wc] = ss;
            }
            asm volatile("" ::: "memory");
        }
    }
};
struct EpiRowScale {
    static constexpr bool PERM = true, AFTER_DRAIN = false;
    bf16_t* O; int ldc; const float* part;
    __device__ __forceinline__ void operator()(const f32x4 (&acc)[2][2][4][2], const Unit& u, int wr, int wc, int fr, int fq) const {
        const int col0 = u.pn * BM + wc * 32 + fq * 8;
        EPI_RS8(part)
        EPI_ROWS(
            const float rs = rsv[ai][m];
            _Pragma("unroll") for (int bj = 0; bj < 2; ++bj) *(u32x4*)(O + (size_t)row * ldc + col0 + bj * HALF) = pack8(acc[ai][bj][m][0] * rs, acc[ai][bj][m][1] * rs);
        )
    }
};
struct EpiVT {
    static constexpr bool PERM = true, AFTER_DRAIN = false;
    bf16_t* O; const float* rsm;
    __device__ __forceinline__ void operator()(const f32x4 (&acc)[2][2][4][2], const Unit& u, int wr, int wc, int fr, int fq) const {
        const int col0 = u.pn * BM + wc * 32 + fq * 8;
        f32x4 s[2][2];
        _Pragma("unroll") for (int bj = 0; bj < 2; ++bj) { s[bj][0] = *(const f32x4*)(rsm + col0 + bj * HALF); s[bj][1] = *(const f32x4*)(rsm + col0 + bj * HALF + 4); }
        EPI_ROWS(
            _Pragma("unroll") for (int bj = 0; bj < 2; ++bj) *(u32x4*)(O + (size_t)row * 4096 + col0 + bj * HALF) = pack8(acc[ai][bj][m][0] * s[bj][0], acc[ai][bj][m][1] * s[bj][1]);
        )
    }
};
struct EpiWin {
    static constexpr bool PERM = true, AFTER_DRAIN = false;
    bf16_t* AP; bf16_t* ZUB; bf16_t* ZVB; f32x2* lnp; const float* part;
    __device__ __forceinline__ void operator()(const f32x4 (&acc)[2][2][4][2], const Unit& u, int wr, int wc, int fr, int fq) const {
        const int cl = wc * 32 + fq * 8;
        EPI_RS8(part)
        EPI_ROWS(
            const float rs = rsv[ai][m];
            if (u.pn < 2) {
                _Pragma("unroll") for (int bj = 0; bj < 2; ++bj) { const int c = u.pn * BM + bj * HALF + cl; const int g = c >> 4;
                    *(u32x4*)(AP + ((size_t)(g * 1536 + (row >> 5)) * 768 + (row & 31) * 16 + (c & 15))) = pack8(acc[ai][bj][m][0] * rs, acc[ai][bj][m][1] * rs); }
            } else if (u.pn < 4) {
                _Pragma("unroll") for (int bj = 0; bj < 2; ++bj) { const int c = (u.pn - 2) * BM + bj * HALF + cl; f32x4 a = acc[ai][bj][m][0] * rs, b = acc[ai][bj][m][1] * rs;
                    a = gelu4(a); b = gelu4(b);
                    *(u32x4*)(ZUB + (size_t)row * 512 + c) = pack8(a, b); }
            } else {
                float s1 = 0.f, s2 = 0.f;
                _Pragma("unroll") for (int bj = 0; bj < 2; ++bj) { const int c = (u.pn - 4) * BM + bj * HALF + cl; f32x4 a = acc[ai][bj][m][0] * rs, b = acc[ai][bj][m][1] * rs;
                    a = gelu4(a); b = gelu4(b); _Pragma("unroll") for (int e = 0; e < 4; ++e) { s1 += a[e] + b[e]; s2 += a[e] * a[e] + b[e] * b[e]; }
                    *(u32x4*)(ZVB + (size_t)row * 512 + c) = pack8(a, b); }
                s1 = fq_sum(s1); s2 = fq_sum(s2);
                if (fq == 0) lnp[(size_t)row * 8 + (u.pn - 4) * 4 + wc] = (f32x2){s1, s2};
            }
        )
    }
};
struct EpiF32 {
    static constexpr bool PERM = true, AFTER_DRAIN = false;
    float* O; int ldc; int rows_per_g;
    __device__ __forceinline__ void operator()(const f32x4 (&acc)[2][2][4][2], const Unit& u, int wr, int wc, int fr, int fq) const {
        const int col0 = u.pn * BM + wc * 32 + fq * 8;
        EPI_ROWS(
            _Pragma("unroll") for (int bj = 0; bj < 2; ++bj) { float* p = O + ((size_t)u.g * rows_per_g + row) * ldc + col0 + bj * HALF; *(f32x4*)p = acc[ai][bj][m][0]; *(f32x4*)(p + 4) = acc[ai][bj][m][1]; }
        )
    }
};
struct EpiS5aScan {
    static constexpr bool PERM = true, AFTER_DRAIN = true;
    float* SST; bf16_t* AP; const f32x2* APOW;
    __device__ __forceinline__ void fused(f32x4 (&acc)[2][2][4][2], const Unit& u, int wr, int wc, int fr, int fq, PG8_LAS unsigned char* lds, int wid, int lane) const {
        const int col0 = wc * 32 + fq * 8;
        EPI_ROWS(
            _Pragma("unroll") for (int bj = 0; bj < 2; ++bj) { float* p = SST + ((size_t)u.g * 1536 + row) * 256 + col0 + bj * HALF; *(f32x4*)p = acc[ai][bj][m][0]; *(f32x4*)(p + 4) = acc[ai][bj][m][1]; }
        )
        asm volatile("s_waitcnt vmcnt(0)" ::: "memory"); __builtin_amdgcn_s_barrier(); asm volatile("" ::: "memory");
        const int tid = wid * 64 + lane, p = tid & 63, dir = (tid >> 6) & 1, sl = tid >> 7;
        const bool prompt = u.pm < 4; const int nch = prompt ? 128 : 64, ch0 = u.pm * 256 + sl * nch;
        if (prompt && sl >= 2) return;
        const f32x2 a32 = APOW[((size_t)(dir * 32 + u.g) * 33 + 32) * 64 + p];
        const float* S = SST + (size_t)u.g * 1536 * 256 + dir * 128 + p; bf16_t* H = AP + (size_t)u.g * 1536 * 768 + 512 + dir * 128 + p;
        float hr = 0.f, hi = 0.f;
#pragma unroll 8
        for (int i = 0; i < nch; ++i) {
            const int ch = ch0 + (dir == 0 ? i : nch - 1 - i);
            const float sr = S[(size_t)ch * 256], si = S[(size_t)ch * 256 + 64];
            H[(size_t)ch * 768] = (bf16_t)(cvt_pk_bf16(hr, 0.f) & 0xffffu); H[(size_t)ch * 768 + 64] = (bf16_t)(cvt_pk_bf16(hi, 0.f) & 0xffffu);
            const float nr = a32.x * hr - a32.y * hi + sr, ni = a32.x * hi + a32.y * hr + si; hr = nr; hi = ni;
        }
    }
};
struct EpiS5c {
    static constexpr bool PERM = true, AFTER_DRAIN = false;
    bf16_t* G;
    __device__ __forceinline__ void operator()(const f32x4 (&acc)[2][2][4][2], const Unit& u, int wr, int wc, int fr, int fq) const {
        const int col0 = u.pn * BM + wc * 32 + fq * 8;
        EPI_ROWS(
            _Pragma("unroll") for (int bj = 0; bj < 2; ++bj) { const int col = col0 + bj * HALF; const int t = col >> 4, c = col & 15; f32x4 a = acc[ai][bj][m][0], b = acc[ai][bj][m][1];
                a = gelu4(a); b = gelu4(b);
                *(u32x4*)(G + ((size_t)(row * 32 + t) * 512 + u.g * 16 + c)) = pack8(a, b); }
        )
    }
};
struct EpiGLU {
    static constexpr bool PERM = true, AFTER_DRAIN = false;
    const bf16_t* G; bf16_t* CAT;
    __device__ __forceinline__ void operator()(const f32x4 (&acc)[2][2][4][2], const Unit& u, int wr, int wc, int fr, int fq) const {
        const int col0 = u.pn * BM + wc * 32 + fq * 8;
        EPI_ROWS(
            _Pragma("unroll") for (int bj = 0; bj < 2; ++bj) { const int col = col0 + bj * HALF; const u32x4 gv = *(const u32x4*)(G + (size_t)row * 512 + col);
                f32x4 a, b; a[0] = bf_lo(gv.x) * sigm(acc[ai][bj][m][0][0]); a[1] = bf_hi(gv.x) * sigm(acc[ai][bj][m][0][1]); a[2] = bf_lo(gv.y) * sigm(acc[ai][bj][m][0][2]); a[3] = bf_hi(gv.y) * sigm(acc[ai][bj][m][0][3]);
                b[0] = bf_lo(gv.z) * sigm(acc[ai][bj][m][1][0]); b[1] = bf_hi(gv.z) * sigm(acc[ai][bj][m][1][1]); b[2] = bf_lo(gv.w) * sigm(acc[ai][bj][m][1][2]); b[3] = bf_hi(gv.w) * sigm(acc[ai][bj][m][1][3]);
                *(u32x4*)(CAT + (size_t)row * 1024 + col) = pack8(a, b); }
        )
    }
};

template <class Epi, class Sched, bool ALIGN_EPI = false, bool SP2 = false>
__device__ __forceinline__ void gemm_phase(PG8_LAS unsigned char* lds, const Gemm g, const Sched& S, const Epi& E) {
    const int tid = opq((int)threadIdx.x), wid = __builtin_amdgcn_readfirstlane(tid >> 6), lane = tid & 63, wr = wid >> 2, wc = wid & 3, fr = lane & 15, fq = lane >> 4;
    const int K = g.K, nt = K / BK, lda = g.lda, ldb = g.ldb;
    unsigned voffA[2], voffB[2];
#pragma unroll
    for (int i = 0; i < 2; ++i) { int R, C; stage_rc(tid * 16 + i * 8192, R, C); const int Rb = Epi::PERM ? ((R & ~31) + perm32(R & 31)) : R;
        voffA[i] = (unsigned)(R * lda + C) * 2u; voffB[i] = (unsigned)(Rb * ldb + C) * 2u; }
    const size_t kstep = (size_t)(BK * 2);
    const size_t hstepA = (size_t)HALF * lda * 2, hstepB = (size_t)HALF * ldb * 2;
    const unsigned ldsw = (unsigned)wid * 1024u;
    const int aoff = lds_byte(wr * 64 + fr, fq * 8), boff = lds_byte(wc * 32 + fr, fq * 8);
#define PG8_SA(b, h) (((b) * 2 + (h)) * HTB)
#define PG8_SB(b, h) ((4 + (b) * 2 + (h)) * HTB)
#define PG8_STAGE(bufoff, gbase, voff) do { _Pragma("unroll") for (int _i = 0; _i < 2; ++_i) \
        __builtin_amdgcn_global_load_lds((const unsigned*)((const char*)(gbase) + (voff)[_i]), (PG8_LAS unsigned*)(lds + (bufoff) + ldsw + _i * 8192), 16, 0, 0); } while (0)
#define PG8_LDA(dst, b, h) do { _Pragma("unroll") for (int m = 0; m < 4; ++m) _Pragma("unroll") for (int k = 0; k < 2; ++k) dst[m][k] = *(const PG8_LAS bf16x8*)(lds + PG8_SA(b, h) + aoff + m * 2048 + k * 1024); } while (0)
#define PG8_LDB(dst, b, h) do { _Pragma("unroll") for (int n = 0; n < 2; ++n) _Pragma("unroll") for (int k = 0; k < 2; ++k) dst[n][k] = *(const PG8_LAS bf16x8*)(lds + PG8_SB(b, h) + boff + n * 2048 + k * 1024); } while (0)
#define PG8_MMA(ai, bj, At, Bt) do { __builtin_amdgcn_s_setprio(1); _Pragma("unroll") for (int m = 0; m < 4; ++m) _Pragma("unroll") for (int n = 0; n < 2; ++n) _Pragma("unroll") for (int k = 0; k < 2; ++k) \
        acc[ai][bj][m][n] = __builtin_amdgcn_mfma_f32_16x16x32_bf16(Bt[n][k], At[m][k], acc[ai][bj][m][n], 0, 0, 0); __builtin_amdgcn_s_setprio(0); } while (0)
#define PG8_WAIT_V(n) asm volatile("s_waitcnt vmcnt(" #n ")" ::: "memory")
#define PG8_WAIT_L(n) asm volatile("s_waitcnt lgkmcnt(" #n ")" ::: "memory")
#define PG8_BAR __builtin_amdgcn_s_barrier()
#define PG8_SCHED __builtin_amdgcn_sched_barrier(0)
    Unit cur, nxt; int ui = 0;
    if (!S.next(0, cur)) return;
    f32x4 acc[2][2][4][2];
#pragma unroll
    for (int a = 0; a < 2; ++a)
#pragma unroll
        for (int b = 0; b < 2; ++b)
#pragma unroll
            for (int m = 0; m < 4; ++m)
#pragma unroll
                for (int n = 0; n < 2; ++n) acc[a][b][m][n] = (f32x4){0.f, 0.f, 0.f, 0.f};
    bf16x8 At[4][2], B0[2][2], B1[2][2];
    const char* cA = (cur.pm < g.pm2 ? (const char*)g.A + (size_t)cur.pm * g.a_pm : (const char*)g.A2 + (size_t)(cur.pm - g.pm2) * g.a_pm) + (size_t)cur.pn * g.a_pn + (size_t)cur.g * g.a_g; const char* cB = (const char*)g.Bt + (size_t)cur.pn * g.b_pn + (size_t)cur.g * g.b_g;
    S.a_ready(cur);
    if constexpr (SP2) {
        PG8_STAGE(PG8_SB(0, 0), cB, voffB); PG8_STAGE(PG8_SB(0, 1), cB + hstepB, voffB); PG8_STAGE(PG8_SA(0, 0), cA, voffA); PG8_STAGE(PG8_SA(0, 1), cA + hstepA, voffA);
        if (wr == 1) PG8_BAR;
        PG8_WAIT_V(2); PG8_BAR;
        PG8_STAGE(PG8_SB(1, 0), cB + kstep, voffB); PG8_STAGE(PG8_SA(1, 0), cA + kstep, voffA); PG8_STAGE(PG8_SB(1, 1), cB + hstepB + kstep, voffB);
        PG8_WAIT_V(6); PG8_BAR;
    } else {
        PG8_STAGE(PG8_SB(0, 0), cB, voffB); PG8_STAGE(PG8_SA(0, 0), cA, voffA); PG8_STAGE(PG8_SB(0, 1), cB + hstepB, voffB); PG8_STAGE(PG8_SA(0, 1), cA + hstepA, voffA);
        if (wr == 1) PG8_BAR;
        PG8_WAIT_V(4); PG8_BAR;
        PG8_STAGE(PG8_SB(1, 0), cB + kstep, voffB); PG8_STAGE(PG8_SA(1, 0), cA + kstep, voffA); PG8_STAGE(PG8_SB(1, 1), cB + hstepB + kstep, voffB);
        PG8_WAIT_V(6); PG8_BAR;
    }
    for (;;) {
        const bool has_next = S.next(ui + 1, nxt);
        const char* nA = has_next ? (nxt.pm < g.pm2 ? (const char*)g.A + (size_t)nxt.pm * g.a_pm : (const char*)g.A2 + (size_t)(nxt.pm - g.pm2) * g.a_pm) + (size_t)nxt.pn * g.a_pn + (size_t)nxt.g * g.a_g : cA; const char* nB = has_next ? (const char*)g.Bt + (size_t)nxt.pn * g.b_pn + (size_t)nxt.g * g.b_g : cB;
        for (int t = 0; t < nt; t += 2) {
            const bool last = (t == nt - 2);
            const char* a1 = cA + (size_t)(t + 1) * kstep;
            const char* a2 = last ? nA : cA + (size_t)(t + 2) * kstep; const char* b2 = last ? nB : cB + (size_t)(t + 2) * kstep;
            const char* a3 = a2 + kstep; const char* b3 = b2 + kstep;
            if (last && has_next) S.a_ready(nxt);
            if constexpr (SP2) {
            PG8_LDB(B0, 0, 0); PG8_LDB(B1, 0, 1); PG8_SCHED; PG8_LDA(At, 0, 0); PG8_STAGE(PG8_SA(1, 1), a1 + hstepA, voffA);
            PG8_WAIT_V(8); PG8_WAIT_L(0); PG8_BAR; PG8_MMA(0, 0, At, B0); PG8_MMA(0, 1, At, B1); PG8_BAR; PG8_SCHED;
            PG8_LDA(At, 0, 1); PG8_STAGE(PG8_SB(0, 0), b2, voffB); PG8_STAGE(PG8_SB(0, 1), b2 + hstepB, voffB); PG8_STAGE(PG8_SA(0, 0), a2, voffA);
            PG8_WAIT_V(8); PG8_WAIT_L(0); PG8_BAR; PG8_MMA(1, 0, At, B0); PG8_MMA(1, 1, At, B1); PG8_BAR; PG8_SCHED;
            PG8_LDB(B0, 1, 0); PG8_LDB(B1, 1, 1); PG8_SCHED; PG8_LDA(At, 1, 0); PG8_STAGE(PG8_SA(0, 1), a2 + hstepA, voffA);
            PG8_WAIT_V(8); PG8_WAIT_L(0); PG8_BAR; PG8_MMA(0, 0, At, B0); PG8_MMA(0, 1, At, B1); PG8_BAR; PG8_SCHED;
            PG8_LDA(At, 1, 1); PG8_STAGE(PG8_SB(1, 0), b3, voffB); PG8_STAGE(PG8_SB(1, 1), b3 + hstepB, voffB); PG8_STAGE(PG8_SA(1, 0), a3, voffA);
            PG8_WAIT_V(8); PG8_WAIT_L(0); PG8_BAR; PG8_MMA(1, 0, At, B0); PG8_MMA(1, 1, At, B1); PG8_BAR; PG8_SCHED;
            } else {
            PG8_LDB(B0, 0, 0); PG8_SCHED; PG8_LDA(At, 0, 0); PG8_STAGE(PG8_SA(1, 1), a1 + hstepA, voffA);
            PG8_WAIT_L(8); PG8_BAR; PG8_WAIT_L(0); PG8_MMA(0, 0, At, B0); PG8_BAR; PG8_SCHED;
            PG8_LDB(B1, 0, 1); PG8_STAGE(PG8_SB(0, 0), b2, voffB);
            PG8_BAR; PG8_WAIT_L(0); PG8_MMA(0, 1, At, B1); PG8_BAR;
            PG8_LDA(At, 0, 1); PG8_STAGE(PG8_SA(0, 0), a2, voffA);
            PG8_BAR; PG8_WAIT_L(0); PG8_MMA(1, 0, At, B0); PG8_BAR; PG8_SCHED;
            PG8_STAGE(PG8_SB(0, 1), b2 + hstepB, voffB);
            PG8_WAIT_V(6); PG8_BAR; PG8_MMA(1, 1, At, B1); PG8_BAR;
            PG8_LDB(B0, 1, 0); PG8_SCHED; PG8_LDA(At, 1, 0); PG8_STAGE(PG8_SA(0, 1), a2 + hstepA, voffA);
            PG8_WAIT_L(8); PG8_BAR; PG8_WAIT_L(0); PG8_MMA(0, 0, At, B0); PG8_BAR; PG8_SCHED;
            PG8_LDB(B1, 1, 1); PG8_STAGE(PG8_SB(1, 0), b3, voffB);
            PG8_BAR; PG8_WAIT_L(0); PG8_MMA(0, 1, At, B1); PG8_BAR;
            PG8_LDA(At, 1, 1); PG8_STAGE(PG8_SA(1, 0), a3, voffA);
            PG8_BAR; PG8_WAIT_L(0); PG8_MMA(1, 0, At, B0); PG8_BAR; PG8_SCHED;
            PG8_STAGE(PG8_SB(1, 1), b3 + hstepB, voffB);
            PG8_WAIT_V(6); PG8_BAR; PG8_MMA(1, 1, At, B1); PG8_BAR;
            }
        }
        if constexpr (ALIGN_EPI) { if (wr == 0) PG8_BAR; }
        if constexpr (!Epi::AFTER_DRAIN) { E(acc, cur, wr, wc, fr, fq); S.done(cur); }
        if (!has_next) break;
#pragma unroll
        for (int a = 0; a < 2; ++a)
#pragma unroll
            for (int b = 0; b < 2; ++b)
#pragma unroll
                for (int m = 0; m < 4; ++m)
#pragma unroll
                    for (int n = 0; n < 2; ++n) acc[a][b][m][n] = (f32x4){0.f, 0.f, 0.f, 0.f};
        cur = nxt; cA = nA; cB = nB; ++ui;
        if constexpr (ALIGN_EPI) { if (wr == 1) PG8_BAR; }
    }
    PG8_WAIT_V(0);
    if constexpr (!ALIGN_EPI) { if (wr == 0) PG8_BAR; }
    PG8_BAR;
    if constexpr (Epi::AFTER_DRAIN) { E.fused(acc, cur, wr, wc, fr, fq, lds, wid, lane); S.done(cur); }
#undef PG8_SA
#undef PG8_SB
#undef PG8_STAGE
#undef PG8_LDA
#undef PG8_LDB
#undef PG8_MMA
#undef PG8_WAIT_V
#undef PG8_WAIT_L
#undef PG8_BAR
#undef PG8_SCHED
}
}

#define LAS __attribute__((address_space(3)))
typedef unsigned short bf16;
typedef unsigned v4u __attribute__((ext_vector_type(4)));
typedef unsigned v2u __attribute__((ext_vector_type(2)));
typedef float f32x4 __attribute__((ext_vector_type(4)));
typedef float f32x2 __attribute__((ext_vector_type(2)));
typedef short bf16x8 __attribute__((ext_vector_type(8)));
using pg8::cvt_pk_bf16; using pg8::bf_lo; using pg8::bf_hi;

constexpr int M = 49152, D = 1024, FF = 4096, NSPLIT = 3, SROWS = M / NSPLIT;
constexpr int LDS_BYTES = 147456;
constexpr size_t MiB = (size_t)1 << 20;
constexpr size_t WS_SSQ0 = 1 * MiB, WS_SSQ1 = 4 * MiB, WS_LNP = 7 * MiB, WS_RSM = 10 * MiB, WS_SSQM = 10 * MiB + 256 * 1024, WS_APOW = 11 * MiB, WS_BBAR = 13 * MiB, WS_WSB = 13 * MiB + 512 * 1024, WS_KTAB = 14 * MiB;
constexpr size_t WS_WGU1 = 16 * MiB, WS_WGU2 = 32 * MiB, WS_WD1 = 48 * MiB, WS_WD2 = 56 * MiB, WS_WQ = 64 * MiB, WS_WKV = 66 * MiB, WS_WO = 70 * MiB, WS_WIN = 72 * MiB, WS_WGLU = 75 * MiB, WS_WOUT = 76 * MiB, WS_WPOOL = 78 * MiB;
constexpr size_t WS_XB = 88 * MiB, WS_MEMB = 184 * MiB, WS_KB = 192 * MiB, WS_VT = 200 * MiB;
constexpr size_t WS_H = 208 * MiB, WS_QO = 208 * MiB, WS_POOLED = 208 * MiB, WS_ZUB = 208 * MiB, WS_ZVB = 256 * MiB, WS_SST = 304 * MiB, WS_GB = 352 * MiB, WS_AP = 400 * MiB, WS_BT = 472 * MiB, WS_B1S = 496 * MiB, WS_CAT = 400 * MiB, WS_END = 504 * MiB;

struct Args { const float* in[36]; float* out; unsigned char* ws; };

#define LDS_WAIT() asm volatile("s_waitcnt lgkmcnt(0)" ::: "memory")
__device__ __forceinline__ float wave_sum(float v) {
#pragma unroll
    for (int o = 1; o < 64; o <<= 1) v += __shfl_xor(v, o);
    return v;
}
__device__ __forceinline__ unsigned short f2bf(float f) { return (unsigned short)(cvt_pk_bf16(f, 0.f) & 0xffffu); }
__device__ __forceinline__ float rsq_eps(float ssq) { return __builtin_amdgcn_rsqf(ssq * (1.0f / 1024.0f) + 1e-6f); }

struct TD { const float* W; const float* gk; const float* gn; bf16* WT; int ldw, k0, n0, ldt, drow_off, mode; float scale; };
__device__ __forceinline__ void td_load(const TD& d, int tid, f32x4 (&v)[8]) {
#pragma unroll
    for (int i = 0; i < 8; ++i) { const int idx = tid + 512 * i, kk = idx >> 6, c4 = idx & 63; v[i] = __builtin_nontemporal_load((const f32x4*)(d.W + (size_t)(d.k0 + kk) * d.ldw + d.n0 + c4 * 4)); }
}
__device__ __forceinline__ void td_store(const TD& d, int tid, const f32x4 (&v)[8], LAS float* scr) {
#pragma unroll
    for (int i = 0; i < 8; ++i) { const int idx = tid + 512 * i, kk = idx >> 6, c4 = idx & 63; const float g = d.gk ? d.gk[d.k0 + kk] : 1.0f;
#pragma unroll
        for (int e = 0; e < 4; ++e) { const int n = c4 * 4 + e; scr[kk * 257 + (n ^ ((n >> 5) & 3))] = v[i][e] * g; } }
    __syncthreads();
#pragma unroll
    for (int j = 0; j < 4; ++j) {
        const int n = (tid >> 2) + 128 * (j >> 1), c = (tid & 3) + 4 * (j & 1), ng = d.n0 + n; const float sc = d.gn ? d.scale * d.gn[ng] : d.scale;
        const LAS float* s = scr + (8 * c) * 257 + (n ^ ((n >> 5) & 3));
        v4u o; o.x = cvt_pk_bf16(s[0 * 257] * sc, s[1 * 257] * sc); o.y = cvt_pk_bf16(s[2 * 257] * sc, s[3 * 257] * sc); o.z = cvt_pk_bf16(s[4 * 257] * sc, s[5 * 257] * sc); o.w = cvt_pk_bf16(s[6 * 257] * sc, s[7 * 257] * sc);
        const int drow = d.mode == 0 ? ng : ((ng >> 7) * 256 + (ng & 127) + (d.mode == 2 ? 128 : 0));
        *(v4u*)(d.WT + (size_t)(d.drow_off + drow) * d.ldt + d.k0 + 8 * c) = o;
    }
    __syncthreads();
}
#define TDS(W_, K_, N_, GK_, SC_, WT_, MODE_) { constexpr int nblk_ = (N_) / 256, cnt_ = ((K_) / 64) * nblk_; if (r < cnt_) { d.W = (W_); d.ldw = (N_); d.k0 = 64 * (r / nblk_); d.n0 = 256 * (r % nblk_); d.gk = (GK_); d.gn = nullptr; d.scale = (SC_); d.WT = (WT_); d.ldt = (K_); d.drow_off = 0; d.mode = (MODE_); return; } r -= cnt_; }
__device__ __forceinline__ void td_desc(const Args& a, unsigned char* ws, int l, int r, TD& d) {
    const size_t LW = (size_t)1024 * 4096;
    const float* g_f1 = a.in[4] + l * 1024; const float* g_f2 = a.in[31] + l * 1024; const float* g_cr = a.in[26] + l * 1024; const float* g_mem = a.in[27] + l * 1024;
    TDS(a.in[5] + l * LW, 1024, 4096, g_f1, 1.0f, (bf16*)(ws + WS_WGU1), 1)
    TDS(a.in[6] + l * LW, 1024, 4096, g_f1, 1.0f, (bf16*)(ws + WS_WGU1), 2)
    TDS(a.in[7] + l * LW, 4096, 1024, nullptr, 1.0f, (bf16*)(ws + WS_WD1), 0)
    TDS(a.in[32] + l * LW, 1024, 4096, g_f2, 1.0f, (bf16*)(ws + WS_WGU2), 1)
    TDS(a.in[33] + l * LW, 1024, 4096, g_f2, 1.0f, (bf16*)(ws + WS_WGU2), 2)
    TDS(a.in[34] + l * LW, 4096, 1024, nullptr, 1.0f, (bf16*)(ws + WS_WD2), 0)
    TDS(a.in[28] + (size_t)l * 1024 * 1024, 1024, 1024, g_cr, 0.0625f * 1.4426950408889634f, (bf16*)(ws + WS_WQ), 0)
    TDS(a.in[29] + (size_t)l * 1024 * 2048, 1024, 2048, g_mem, 1.0f, (bf16*)(ws + WS_WKV), 0)
    TDS(a.in[30] + (size_t)l * 1024 * 1024, 1024, 1024, nullptr, 1.0f, (bf16*)(ws + WS_WO), 0)
    if (l == 0) {
        TDS(a.in[9], 1024, 1536, a.in[8], 1.0f, (bf16*)(ws + WS_WIN), 0)
        TDS(a.in[18], 512, 512, nullptr, 1.0f, (bf16*)(ws + WS_WGLU), 0)
        TDS(a.in[23], 1024, 1024, nullptr, 1.0f, (bf16*)(ws + WS_WOUT), 0)
    }
    { const int gi = (r >> 2) & 3, kb = r & 3;
      d.W = a.in[24] + (size_t)gi * 65536; d.ldw = 256; d.k0 = 64 * kb; d.n0 = 0; d.gk = a.in[8] + 1024 + gi * 256; d.gn = a.in[25] + gi * 256; d.scale = 1.0f; d.WT = (bf16*)(ws + WS_WPOOL); d.ldt = 256; d.drow_off = gi * 256; d.mode = 0; }
}
__device__ __forceinline__ void prep_weights(const Args& a, unsigned char* ws, LAS unsigned char* lds, int l, int bx, int G, int tid, int sel) {
    tid = opq(tid);
    LAS float* scr = (LAS float*)lds;
    const int nall = 6 * 256 + 64 + 128 + 64 + (l == 0 ? 96 + 16 + 64 : 16);
    const int nitems = sel == 0 ? nall : sel == 1 ? 768 + (nall - 1536) : sel == 2 ? 512 : 256;
#define PW_MAP(i_) (sel == 0 ? (i_) : sel == 1 ? ((i_) < 768 ? (i_) : (i_) + 768) : sel == 2 ? (i_) + 768 : (i_) + 1280)
    int it = bx; if (it >= nitems) return;
    TD cur; td_desc(a, ws, l, PW_MAP(it), cur);
    f32x4 v[8]; td_load(cur, tid, v);
    for (;;) {
        const int itn = it + G; const bool more = itn < nitems;
        TD nxt = cur; f32x4 vn[8];
        if (more) { td_desc(a, ws, l, PW_MAP(itn), nxt); td_load(nxt, tid, vn); }
        td_store(cur, tid, v, scr);
        if (!more) break;
#pragma unroll
        for (int i = 0; i < 8; ++i) v[i] = vn[i];
        cur = nxt; it = itn;
    }
#undef PW_MAP
}

__device__ __forceinline__ void sincos_turns(double t, double& c, double& s) {
    t -= __builtin_rint(t);
    const double n = __builtin_rint(4.0 * t); const double r = t - 0.25 * n; const double x = 6.283185307179586476925 * r, x2 = x * x;
    double sp = -7.647163731819816e-13; sp = sp * x2 + 1.605904383682161e-10; sp = sp * x2 - 2.505210838544172e-08; sp = sp * x2 + 2.755731922398589e-06; sp = sp * x2 - 1.984126984126984e-04; sp = sp * x2 + 8.333333333333333e-03; sp = sp * x2 - 1.666666666666667e-01; sp = sp * x2 * x + x;
    double cp = 4.779477332387385e-14; cp = cp * x2 - 1.147074559772972e-11; cp = cp * x2 + 2.087675698786810e-09; cp = cp * x2 - 2.755731922398589e-07; cp = cp * x2 + 2.480158730158730e-05; cp = cp * x2 - 1.388888888888889e-03; cp = cp * x2 + 4.166666666666666e-02; cp = cp * x2 - 0.5; cp = cp * x2 + 1.0;
    const int q = ((int)n) & 3;
    c = (q == 0) ? cp : (q == 1) ? -sp : (q == 2) ? -cp : sp;
    s = (q == 0) ? sp : (q == 1) ? cp : (q == 2) ? -sp : -cp;
}
__device__ __forceinline__ void prep_misc(const Args& a, unsigned char* ws, int gw, int NGW, int gt, int NT, int lane) {
    gw = opq(gw); gt = opq(gt); lane = opq(lane);
    bf16* XB = (bf16*)(ws + WS_XB); float* SSQ0 = (float*)(ws + WS_SSQ0);
    for (int r0 = gw; r0 < M; r0 += 4 * NGW) {
        f32x4 v[4][4];
#pragma unroll
        for (int q = 0; q < 4; ++q) { const int r = r0 + q * NGW < M ? r0 + q * NGW : r0; const float* src = r < 32768 ? a.in[0] + (size_t)r * D : a.in[1] + (size_t)(r - 32768) * D;
#pragma unroll
            for (int j = 0; j < 4; ++j) v[q][j] = __builtin_nontemporal_load((const f32x4*)src + lane + 64 * j); }
#pragma unroll
        for (int q = 0; q < 4; ++q) { const int r = r0 + q * NGW < M ? r0 + q * NGW : r0; float s = 0.f;
#pragma unroll
            for (int j = 0; j < 4; ++j) { const f32x4 x = v[q][j]; s += (x[0] * x[0] + x[1] * x[1]) + (x[2] * x[2] + x[3] * x[3]);
                v2u w; w.x = cvt_pk_bf16(x[0], x[1]); w.y = cvt_pk_bf16(x[2], x[3]); ((v2u*)(XB + (size_t)r * D))[lane + 64 * j] = w; }
            s = wave_sum(s);
            if (lane < 16) SSQ0[(size_t)r * 16 + lane] = lane == 0 ? s : 0.f; }
    }
    bf16* MEMB = (bf16*)(ws + WS_MEMB); float* SSQM = (float*)(ws + WS_SSQM); float* RSM = (float*)(ws + WS_RSM);
    for (int r = gw; r < 4096; r += NGW) {
        const float* src = r < 2048 ? a.in[2] + (size_t)r * D : a.in[3] + (size_t)(r - 2048) * D;
        float s = 0.f;
#pragma unroll
        for (int j = 0; j < 4; ++j) { const f32x4 v = __builtin_nontemporal_load((const f32x4*)src + lane + 64 * j); s += (v[0] * v[0] + v[1] * v[1]) + (v[2] * v[2] + v[3] * v[3]);
            v2u w; w.x = cvt_pk_bf16(v[0], v[1]); w.y = cvt_pk_bf16(v[2], v[3]); ((v2u*)(MEMB + (size_t)r * D))[lane + 64 * j] = w; }
        s = wave_sum(s);
        if (lane < 16) SSQM[(size_t)r * 16 + lane] = lane == 0 ? s : 0.f;
        if (lane == 0) RSM[r] = rsq_eps(s);
    }
    { bf16* WSB = (bf16*)(ws + WS_WSB); for (int i = gt; i < 4 * 128 * 128; i += NT) WSB[i] = f2bf(a.in[21][i]); }
    f32x2* APOW = (f32x2*)(ws + WS_APOW); f32x2* BBAR = (f32x2*)(ws + WS_BBAR);
    for (int idx = gt; idx < 2 * 32 * 64; idx += NT) {
        const int p = idx & 63, dg = idx >> 6;
        const double lre = (double)a.in[10][idx], lim = (double)a.in[11][idx]; const double dt = exp((double)a.in[12][dg]);
        const double lr = lre * dt, tn = lim * dt * 0.15915494309189533577;
        double a1r = 0., a1i = 0.;
        for (int k = 0; k <= 32; ++k) { const double mag = exp((double)k * lr); double c, s; sincos_turns((double)k * tn, c, s); APOW[((size_t)dg * 33 + k) * 64 + p] = (f32x2){(float)(mag * c), (float)(mag * s)}; if (k == 1) { a1r = mag * c; a1i = mag * s; } }
        const double nr = a1r - 1.0, ni = a1i, den = lre * lre + lim * lim; const double qr = (nr * lre + ni * lim) / den, qi = (ni * lre - nr * lim) / den;
#pragma unroll 4
        for (int c = 0; c < 16; ++c) { const double br = (double)a.in[13][(size_t)idx * 16 + c], bi = (double)a.in[14][(size_t)idx * 16 + c]; BBAR[(size_t)idx * 16 + c] = (f32x2){(float)(qr * br - qi * bi), (float)(qr * bi + qi * br)}; }
    }
}
__device__ __forceinline__ void s5_tab2(const Args& a, unsigned char* ws, int gt, int NT) {
    gt = opq(gt);
    const f32x2* APOW = (const f32x2*)(ws + WS_APOW); const f32x2* BBAR = (const f32x2*)(ws + WS_BBAR); float* KTAB = (float*)(ws + WS_KTAB);
    for (int e = gt; e < 32 * 2 * 32 * 256; e += NT) {
        const int cc = e & 15, c = (e >> 4) & 15, k = (e >> 8) & 31, dir = (e >> 13) & 1, g = e >> 14, dg = dir * 32 + g;
        const f32x2* ap = APOW + ((size_t)dg * 33 + k) * 64; const float* cre = a.in[15] + ((size_t)dg * 16 + c) * 64; const float* cim = a.in[16] + ((size_t)dg * 16 + c) * 64; const f32x2* bb = BBAR + (size_t)dg * 1024 + cc;
        float acc = 0.f;
#pragma unroll 8
        for (int p = 0; p < 64; ++p) { const f32x2 av = ap[p]; const float cr = cre[p], ci = cim[p]; const float car = cr * av.x - ci * av.y, cai = cr * av.y + ci * av.x; const f32x2 b = bb[p * 16]; acc += car * b.x - cai * b.y; }
        KTAB[e] = acc;
    }
}
__device__ __forceinline__ void s5_tab3(const Args& a, unsigned char* ws, int gt, int NT) {
    gt = opq(gt);
    const f32x2* APOW = (const f32x2*)(ws + WS_APOW); const f32x2* BBAR = (const f32x2*)(ws + WS_BBAR); const float* KTAB = (const float*)(ws + WS_KTAB);
    bf16* BT = (bf16*)(ws + WS_BT); bf16* B1S = (bf16*)(ws + WS_B1S);
    for (int idx = gt; idx < 32 * 512 * 96; idx += NT) {
        const int kp = idx % 96, n = (idx / 96) & 511, g = idx / (96 * 512), t = n >> 4, c = n & 15;
        float v[8];
        if (kp < 64) {
            const int s = kp >> 1, c0 = (kp & 1) * 8;
            if (s != t) { const int dir = s < t ? 0 : 1, k = s < t ? t - s : s - t; const f32x4* kt = (const f32x4*)(KTAB + ((size_t)((g * 2 + dir) * 32 + k) * 256 + c * 16 + c0)); const f32x4 x0 = kt[0], x1 = kt[1];
                v[0] = x0[0]; v[1] = x0[1]; v[2] = x0[2]; v[3] = x0[3]; v[4] = x1[0]; v[5] = x1[1]; v[6] = x1[2]; v[7] = x1[3]; }
            else { const f32x4* k0 = (const f32x4*)(KTAB + ((size_t)((g * 2 + 0) * 32) * 256 + c * 16 + c0)); const f32x4* k1 = (const f32x4*)(KTAB + ((size_t)((g * 2 + 1) * 32) * 256 + c * 16 + c0));
                const f32x4 x0 = k0[0] + k1[0], x1 = k0[1] + k1[1]; const float dv = a.in[17][g * 16 + c];
                v[0] = x0[0]; v[1] = x0[1]; v[2] = x0[2]; v[3] = x0[3]; v[4] = x1[0]; v[5] = x1[1]; v[6] = x1[2]; v[7] = x1[3];
#pragma unroll
                for (int i = 0; i < 8; ++i) v[i] += (c == c0 + i) ? dv : 0.f; }
        } else {
            const int j = kp - 64, dir = j >> 4, i8 = (j & 15) * 8, im = i8 >> 6, p0 = i8 & 63, e = dir == 0 ? t + 1 : 32 - t, dg = dir * 32 + g;
            const f32x2* ap = APOW + ((size_t)dg * 33 + e) * 64 + p0; const float* cre = a.in[15] + ((size_t)dg * 16 + c) * 64 + p0; const float* cim = a.in[16] + ((size_t)dg * 16 + c) * 64 + p0;
#pragma unroll
            for (int i = 0; i < 8; ++i) { const f32x2 av = ap[i]; const float cr = cre[i], ci = cim[i]; v[i] = im ? -(cr * av.y + ci * av.x) : (cr * av.x - ci * av.y); }
        }
        v4u o; o.x = cvt_pk_bf16(v[0], v[1]); o.y = cvt_pk_bf16(v[2], v[3]); o.z = cvt_pk_bf16(v[4], v[5]); o.w = cvt_pk_bf16(v[6], v[7]);
        *(v4u*)(BT + ((size_t)(g * 512 + n) * 768 + kp * 8)) = o;
    }
    for (int idx = gt; idx < 32 * 256 * 64; idx += NT) {
        const int kp = idx & 63, n = (idx >> 6) & 255, g = idx >> 14, s = kp >> 1, c0 = (kp & 1) * 8, dir = n >> 7, im = (n >> 6) & 1, p = n & 63, e = dir == 0 ? 31 - s : s, dg = dir * 32 + g;
        const f32x2 av = APOW[((size_t)dg * 33 + e) * 64 + p]; const f32x2* bb = BBAR + ((size_t)dg * 64 + p) * 16 + c0;
        float v[8];
#pragma unroll
        for (int i = 0; i < 8; ++i) { const f32x2 b = bb[i]; v[i] = im ? (av.x * b.y + av.y * b.x) : (av.x * b.x - av.y * b.y); }
        v4u o; o.x = cvt_pk_bf16(v[0], v[1]); o.y = cvt_pk_bf16(v[2], v[3]); o.z = cvt_pk_bf16(v[4], v[5]); o.w = cvt_pk_bf16(v[6], v[7]);
        *(v4u*)(B1S + ((size_t)(g * 256 + n) * 512 + kp * 8)) = o;
    }
}
__device__ __forceinline__ void s5_scan(unsigned char* ws, int gt) {
    gt = opq(gt);
    if (gt >= 16 * 32 * 2 * 64) return;
    const int p = gt & 63, dir = (gt >> 6) & 1, g = (gt >> 7) & 31, seq = gt >> 12;
    const int ch0 = seq < 8 ? seq * 128 : 1024 + (seq - 8) * 64, nch = seq < 8 ? 128 : 64;
    const f32x2 a32 = ((const f32x2*)(ws + WS_APOW))[((size_t)(dir * 32 + g) * 33 + 32) * 64 + p];
    const float* S = (const float*)(ws + WS_SST) + (size_t)g * 1536 * 256 + dir * 128 + p; bf16* AP = (bf16*)(ws + WS_AP) + (size_t)g * 1536 * 768 + 512 + dir * 128 + p;
    float hr = 0.f, hi = 0.f;
#pragma unroll 8
    for (int i = 0; i < nch; ++i) {
        const int ch = ch0 + (dir == 0 ? i : nch - 1 - i);
        const float sr = S[(size_t)ch * 256], si = S[(size_t)ch * 256 + 64];
        AP[(size_t)ch * 768] = f2bf(hr); AP[(size_t)ch * 768 + 64] = f2bf(hi);
        const float nr = a32.x * hr - a32.y * hi + sr, ni = a32.x * hi + a32.y * hr + si; hr = nr; hi = ni;
    }
}
__device__ __forceinline__ void sgu_phase(LAS unsigned char* lds, const Args& a, unsigned char* ws, int ubeg, int uend, int rel, int nrel, int tid) {
    if (rel < 0) return;
    const int tid0 = tid;
    const bf16* ZUB = (const bf16*)(ws + WS_ZUB); const bf16* ZVB = (const bf16*)(ws + WS_ZVB); const float* LNP = (const float*)(ws + WS_LNP); const bf16* WSB = (const bf16*)(ws + WS_WSB); bf16* CAT = (bf16*)a.out;
    const float* ng = a.in[19]; const float* nb = a.in[20]; const float* bs = a.in[22];
    LAS bf16* VTl = (LAS bf16*)lds;
    for (int unit = ubeg + rel; unit < uend; unit += nrel) {
        const int tid = opq(tid0), lane = tid & 63, wave = tid >> 6, fr = lane & 15, fq = lane >> 4;
        const int ck = unit >> 2, h = unit & 3, tok0 = ck * 128, j = tid >> 2;
        float s1 = 0.f, s2 = 0.f;
        { const f32x4* lp = (const f32x4*)(LNP + (size_t)(tok0 + j) * 16);
#pragma unroll
          for (int q = 0; q < 4; ++q) { const f32x4 v = lp[q]; s1 += v[0] + v[2]; s2 += v[1] + v[3]; } }
        const float mean = s1 * (1.0f / 512.0f), var = s2 * (1.0f / 512.0f) - mean * mean, rstd = __builtin_amdgcn_rsqf(var + 1e-6f);
#pragma unroll
        for (int it = 0; it < 4; ++it) {
            const int d0 = ((tid & 3) + 4 * it) * 8;
            const v4u raw = *(const v4u*)(ZVB + (size_t)(tok0 + j) * 512 + h * 128 + d0);
            const f32x4 g0 = *(const f32x4*)(ng + h * 128 + d0), g1 = *(const f32x4*)(ng + h * 128 + d0 + 4), b0 = *(const f32x4*)(nb + h * 128 + d0), b1 = *(const f32x4*)(nb + h * 128 + d0 + 4);
            float x[8] = {bf_lo(raw.x), bf_hi(raw.x), bf_lo(raw.y), bf_hi(raw.y), bf_lo(raw.z), bf_hi(raw.z), bf_lo(raw.w), bf_hi(raw.w)};
#pragma unroll
            for (int e = 0; e < 8; ++e) { const float gg = e < 4 ? g0[e & 3] : g1[e & 3], bb = e < 4 ? b0[e & 3] : b1[e & 3]; VTl[(d0 + e) * 136 + j] = f2bf((x[e] - mean) * rstd * gg + bb); }
        }
        __syncthreads();
        bf16x8 wsf[4];
#pragma unroll
        for (int kk = 0; kk < 4; ++kk) wsf[kk] = *(const bf16x8*)(WSB + (size_t)(h * 128 + wave * 16 + fr) * 128 + 32 * kk + 8 * fq);
        f32x4 acc[8];
#pragma unroll
        for (int dt = 0; dt < 8; ++dt) acc[dt] = (f32x4){0.f, 0.f, 0.f, 0.f};
#pragma unroll
        for (int kk = 0; kk < 4; ++kk)
#pragma unroll
            for (int dt = 0; dt < 8; ++dt) { const bf16x8 vf = *(const LAS bf16x8*)(VTl + (16 * dt + fr) * 136 + 32 * kk + 8 * fq); acc[dt] = __builtin_amdgcn_mfma_f32_16x16x32_bf16(vf, wsf[kk], acc[dt], 0, 0, 0); }
        const int token = tok0 + wave * 16 + fr; const float bias = bs[h * 128 + wave * 16 + fr];
#pragma unroll
        for (int dt = 0; dt < 8; ++dt) { const int d = 16 * dt + 4 * fq; const v2u ub = *(const v2u*)(ZUB + (size_t)token * 512 + h * 128 + d);
            v2u o; o.x = cvt_pk_bf16(bf_lo(ub.x) * (acc[dt][0] + bias), bf_hi(ub.x) * (acc[dt][1] + bias)); o.y = cvt_pk_bf16(bf_lo(ub.y) * (acc[dt][2] + bias), bf_hi(ub.y) * (acc[dt][3] + bias));
            *(v2u*)(CAT + (size_t)token * 1024 + 512 + h * 128 + d) = o; }
        __syncthreads();
    }
}
__device__ __forceinline__ void pool_phase(LAS unsigned char* lds, const bf16* XB, const float* part, bf16* P, int G, int bx, int tid0) {
    LAS float* tile = (LAS float*)lds;
    LAS float* rsl = (LAS float*)(lds + 98304);
    for (int unit = bx; unit < 3072; unit += G) {
        const int tid = opq(tid0);
        const int t0 = (unit >> 1) * 32, hf = unit & 1; const int seq0 = t0 < 32768 ? (t0 & ~4095) : (t0 & ~2047), L = t0 < 32768 ? 4096 : 2048;
        __syncthreads();
        if (tid < 48) { int r = t0 - 8 + tid; r = r < 0 ? 0 : (r > M - 1 ? M - 1 : r); const f32x4* pp = (const f32x4*)(part + (size_t)r * 16); const f32x4 s4 = (pp[0] + pp[1]) + (pp[2] + pp[3]); rsl[tid] = rsq_eps((s4[0] + s4[1]) + (s4[2] + s4[3])); }
        v2u v[12];
#pragma unroll
        for (int i = 0; i < 12; ++i) { const int idx = tid + 512 * i, row = idx >> 7, q = idx & 127; int r = t0 - 8 + row; r = r < 0 ? 0 : (r > M - 1 ? M - 1 : r); v[i] = __builtin_nontemporal_load((const v2u*)(XB + (size_t)r * 1024 + hf * 512 + q * 4)); }
        __syncthreads();
#pragma unroll
        for (int i = 0; i < 12; ++i) { const int idx = tid + 512 * i, row = idx >> 7, q = idx & 127; *(LAS f32x4*)(tile + row * 512 + q * 4) = (f32x4){bf_lo(v[i].x), bf_hi(v[i].x), bf_lo(v[i].y), bf_hi(v[i].y)} * rsl[row]; }
        __syncthreads();
        const int q = tid & 127, rg = tid >> 7, ch0 = hf * 512 + q * 4, gi = ch0 >> 8, hw = 1 << gi;
        int pos = t0 + rg * 8 - seq0; const int lr0 = 8 - (t0 - seq0);
#define TL(p_) (*(const LAS f32x4*)(tile + ((p_) + lr0) * 512 + q * 4))
        f32x4 s = (f32x4){0.f, 0.f, 0.f, 0.f};
        { const int lo = pos - hw < 0 ? 0 : pos - hw, hi = pos + hw > L ? L : pos + hw; for (int j2 = lo; j2 < hi; ++j2) s += TL(j2); }
#pragma unroll
        for (int i = 0; i < 8; ++i, ++pos) {
            const int lo = pos - hw < 0 ? 0 : pos - hw, hi = pos + hw > L ? L : pos + hw;
            const f32x4 o = s * (1.0f / (float)(hi - lo)) - TL(pos);
            v2u w; w.x = cvt_pk_bf16(o[0], o[1]); w.y = cvt_pk_bf16(o[2], o[3]); *(v2u*)(P + (size_t)(seq0 + pos) * 1024 + ch0) = w;
            if (i < 7) { if (pos + hw < L) s += TL(pos + hw); if (pos - hw >= 0) s -= TL(pos - hw); }
        }
#undef TL
    }
}
__device__ __forceinline__ void attn_phase(LAS unsigned char* lds, const bf16* QO, bf16* OB, const bf16* KB, const bf16* VT, int G, int bx, int tid) {
    constexpr int BUF = 69632;
    const int tid0 = tid;
    for (int unit = bx; unit < 768; unit += G) {
        const int tid = opq(tid0), lane = tid & 63, wave = tid >> 6, fr = lane & 15, fq = lane >> 4;
        int b16, h, row0;
        if (unit < 512) { b16 = unit >> 6; h = (unit >> 4) & 3; row0 = b16 * 4096 + (unit & 15) * 256; }
        else { const int u2 = unit - 512; b16 = 8 + (u2 >> 5); h = (u2 >> 3) & 3; row0 = 32768 + (b16 - 8) * 2048 + (u2 & 7) * 256; }
        const size_t qoff = (size_t)(row0 + wave * 32 + fr) * 1024 + h * 256;
        bf16x8 qf[2][8];
#pragma unroll
        for (int t = 0; t < 2; ++t)
#pragma unroll
            for (int kk = 0; kk < 8; ++kk) qf[t][kk] = *(const bf16x8*)(QO + qoff + (size_t)t * 16 * 1024 + 32 * kk + 8 * fq);
        const bf16* kbase = KB + (size_t)(b16 * 256) * 1024 + h * 256;
#pragma unroll
        for (int hh = 0; hh < 2; ++hh) {
            v4u tmp[8];
#pragma unroll
            for (int it = 0; it < 8; ++it) tmp[it] = *(const v4u*)(kbase + (size_t)(hh * 128 + (tid >> 5) + 16 * it) * 1024 + (tid & 31) * 8);
#pragma unroll
            for (int it = 0; it < 8; ++it) *(LAS v4u*)(lds + hh * BUF + ((tid >> 5) + 16 * it) * 528 + (tid & 31) * 16) = tmp[it];
        }
        __syncthreads();
        f32x4 sacc[2][16];
#pragma unroll
        for (int n = 0; n < 16; ++n) { sacc[0][n] = (f32x4){0.f, 0.f, 0.f, 0.f}; sacc[1][n] = (f32x4){0.f, 0.f, 0.f, 0.f}; }
        {
#define KRD(i_) (*(const LAS bf16x8*)(lds + ((i_) >> 6) * BUF + ((((i_) >> 3) & 7) * 16 + fr) * 528 + (32 * ((i_) & 7) + 8 * fq) * 2))
            bf16x8 kfb[4];
#pragma unroll
            for (int i = 0; i < 4; ++i) kfb[i] = KRD(i);
#pragma unroll
            for (int i = 0; i < 128; ++i) { const bf16x8 c = kfb[i & 3]; if (i + 4 < 128) kfb[i & 3] = KRD(i + 4);
                sacc[0][i >> 3] = __builtin_amdgcn_mfma_f32_16x16x32_bf16(c, qf[0][i & 7], sacc[0][i >> 3], 0, 0, 0); sacc[1][i >> 3] = __builtin_amdgcn_mfma_f32_16x16x32_bf16(c, qf[1][i & 7], sacc[1][i >> 3], 0, 0, 0); }
#undef KRD
        }
        __syncthreads();
        const bf16* vbase = VT + (size_t)(h * 256) * 4096 + b16 * 256;
        bf16x8 pf[2][8]; float inv[2];
#pragma unroll
        for (int t = 0; t < 2; ++t) {
            v4u tmp[8];
#pragma unroll
            for (int it = 0; it < 8; ++it) tmp[it] = *(const v4u*)(vbase + (size_t)((tid >> 4) + 32 * it) * 4096 + t * 128 + (tid & 15) * 8);
            float mx = -3.0e38f;
#pragma unroll
            for (int n = 0; n < 16; ++n) mx = fmaxf(fmaxf(mx, fmaxf(sacc[t][n][0], sacc[t][n][1])), fmaxf(sacc[t][n][2], sacc[t][n][3]));
            mx = fmaxf(mx, __shfl_xor(mx, 16)); mx = fmaxf(mx, __shfl_xor(mx, 32));
            float lsum = 0.f;
#pragma unroll
            for (int n = 0; n < 16; ++n) {
#pragma unroll
                for (int e2 = 0; e2 < 4; ++e2) { const float pv = __builtin_amdgcn_exp2f(sacc[t][n][e2] - mx); sacc[t][n][e2] = pv; lsum += pv; } }
            lsum += __shfl_xor(lsum, 16); lsum += __shfl_xor(lsum, 32);
            inv[t] = __builtin_amdgcn_rcpf(lsum);
#pragma unroll
            for (int kk = 0; kk < 8; ++kk) { v4u w; w.x = cvt_pk_bf16(sacc[t][2 * kk][0], sacc[t][2 * kk][1]); w.y = cvt_pk_bf16(sacc[t][2 * kk][2], sacc[t][2 * kk][3]); w.z = cvt_pk_bf16(sacc[t][2 * kk + 1][0], sacc[t][2 * kk + 1][1]); w.w = cvt_pk_bf16(sacc[t][2 * kk + 1][2], sacc[t][2 * kk + 1][3]); pf[t][kk] = __builtin_bit_cast(bf16x8, w); }
#pragma unroll
            for (int it = 0; it < 8; ++it) *(LAS v4u*)(lds + t * BUF + ((tid >> 4) + 32 * it) * 272 + (tid & 15) * 16) = tmp[it];
        }
        __syncthreads();
        {
#define VRD(i_, off_) (*(const LAS v2u*)(lds + (((i_) & 7) >> 2) * BUF + (16 * ((i_) >> 3) + fr) * 272 + ((((i_) & 7) & 3) * 32 + 4 * fq) * 2 + (off_)))
            v2u vlo[4], vhi[4];
#pragma unroll
            for (int i = 0; i < 4; ++i) { vlo[i] = VRD(i, 0); vhi[i] = VRD(i, 32); }
            f32x4 o0 = (f32x4){0.f, 0.f, 0.f, 0.f}, o1 = (f32x4){0.f, 0.f, 0.f, 0.f};
#pragma unroll
            for (int i = 0; i < 128; ++i) {
                v4u w; w.x = vlo[i & 3].x; w.y = vlo[i & 3].y; w.z = vhi[i & 3].x; w.w = vhi[i & 3].y; const bf16x8 vf = __builtin_bit_cast(bf16x8, w);
                if (i + 4 < 128) { vlo[i & 3] = VRD(i + 4, 0); vhi[i & 3] = VRD(i + 4, 32); }
                o0 = __builtin_amdgcn_mfma_f32_16x16x32_bf16(vf, pf[0][i & 7], o0, 0, 0, 0); o1 = __builtin_amdgcn_mfma_f32_16x16x32_bf16(vf, pf[1][i & 7], o1, 0, 0, 0);
                if ((i & 7) == 7) { const int dt = i >> 3;
                    v2u ow; ow.x = cvt_pk_bf16(o0[0] * inv[0], o0[1] * inv[0]); ow.y = cvt_pk_bf16(o0[2] * inv[0], o0[3] * inv[0]);
                    *(v2u*)(OB + qoff + 16 * dt + 4 * fq) = ow;
                    ow.x = cvt_pk_bf16(o1[0] * inv[1], o1[1] * inv[1]); ow.y = cvt_pk_bf16(o1[2] * inv[1], o1[3] * inv[1]);
                    *(v2u*)(OB + qoff + (size_t)16 * 1024 + 16 * dt + 4 * fq) = ow;
                    o0 = (f32x4){0.f, 0.f, 0.f, 0.f}; o1 = (f32x4){0.f, 0.f, 0.f, 0.f}; }
            }
#undef VRD
        }
        __syncthreads();
    }
}

#define XB_TMO      128
#define XB_XCNT(j)  (256  + 64 * (j))
#define XB_XSUB(j)  (1280 + 64 * (j))
#define XB_XGEN(j)  (2304 + 64 * (j))
#define XB_TOP      3328
#define XB_TOPGEN   3392
#define XCD_BAR_WORDS 3456
#define XB_SPIN_CAP (1u << 18)

__device__ __forceinline__ unsigned xb_ld(unsigned* p)              { return __hip_atomic_load(p, __ATOMIC_RELAXED, __HIP_MEMORY_SCOPE_AGENT); }
__device__ __forceinline__ unsigned xb_add(unsigned* p, unsigned v) { return __hip_atomic_fetch_add(p, v, __ATOMIC_RELAXED, __HIP_MEMORY_SCOPE_AGENT); }
__device__ __forceinline__ unsigned xb_xcc_id() { return (unsigned)__builtin_amdgcn_s_getreg((3 << 11) | 20) & 0xFu; }
#define XB_SPIN(cond, bar) do { unsigned _sp = 0; while (cond) { __builtin_amdgcn_s_sleep(1); \
    if ((++_sp & 255u) == 0u) { if (xb_ld(&(bar)[XB_TMO])) break; if (_sp > XB_SPIN_CAP) { atomicAdd(&(bar)[XB_TMO], 1u); break; } } } } while (0)

struct XcdBarrier {
    unsigned* bar; unsigned x;
    volatile LAS unsigned* st;
};

__device__ __forceinline__ XcdBarrier xcd_barrier_post(unsigned* bar, volatile LAS unsigned* st) {
    XcdBarrier b; b.bar = bar; b.x = xb_xcc_id(); b.st = st;
    if (threadIdx.x == 0) (void)xb_add(&bar[XB_XCNT(b.x)], 1u);
    return b;
}
__device__ __forceinline__ void xcd_barrier_complete(unsigned* bar, unsigned x, unsigned& nloc, unsigned& nx) {
    const unsigned G = gridDim.x * gridDim.y * gridDim.z;
    unsigned sum, cnt, mine, sp = 0u;
    for (;;) {
        sum = 0u; cnt = 0u; mine = 0u;
#pragma unroll
        for (unsigned j = 0; j < 16; ++j) { const unsigned c = xb_ld(&bar[XB_XCNT(j)]); sum += c; cnt += (c > 0u) ? 1u : 0u; mine = (j == x) ? c : mine; }
        if (sum == G) break;
        __builtin_amdgcn_s_sleep(1);
        if ((++sp & 255u) == 0u) { if (xb_ld(&bar[XB_TMO])) break; if (sp > XB_SPIN_CAP) { atomicAdd(&bar[XB_TMO], 1u); break; } }
    }
    nloc = mine > 0u ? mine : 1u; nx = cnt > 0u ? cnt : 1u;
}

__device__ __forceinline__ void xcd_barrier(const XcdBarrier& b) {
    asm volatile("s_waitcnt vmcnt(0)" ::: "memory");
    __syncthreads();
    if (threadIdx.x == 0) {
        unsigned* bar = b.bar;
        __builtin_amdgcn_s_waitcnt(0);
        unsigned nloc = b.st[0], nx = b.st[1];
        if (nloc == 0u) { xcd_barrier_complete(bar, b.x, nloc, nx); b.st[0] = nloc; b.st[1] = nx; }
        const unsigned old = xb_add(&bar[XB_XSUB(b.x)], 1u);
        const unsigned gen = old / nloc;
        if (old + 1u == (gen + 1u) * nloc) {
            __builtin_amdgcn_fence(__ATOMIC_RELEASE, "agent");
            asm volatile("s_waitcnt vmcnt(0)" ::: "memory");
            const unsigned og = xb_add(&bar[XB_TOP], 1u);
            const unsigned tg = og / nx;
            if (og + 1u == (tg + 1u) * nx) xb_add(&bar[XB_TOPGEN], 1u);
            else XB_SPIN(xb_ld(&bar[XB_TOPGEN]) == tg, bar);
            __builtin_amdgcn_fence(__ATOMIC_ACQUIRE, "agent");
            xb_add(&bar[XB_XGEN(b.x)], 1u);
            asm volatile("s_waitcnt vmcnt(0)" ::: "memory");
        } else {
            XB_SPIN(xb_ld(&bar[XB_XGEN(b.x)]) == gen, bar);
            __builtin_amdgcn_fence(__ATOMIC_ACQUIRE, "agent");
            asm volatile("s_waitcnt vmcnt(0)" ::: "memory");
        }
    }
    __syncthreads();
}

__device__ __forceinline__ void final_phase(float* OUT, const bf16* XB, const float* part, const float* gain, int gw, int NGW, int lane) {
    gw = opq(gw); lane = opq(lane);
    f32x4 g[4];
#pragma unroll
    for (int j = 0; j < 4; ++j) g[j] = ((const f32x4*)gain)[lane + 64 * j];
    for (int r0 = gw; r0 < M; r0 += 4 * NGW) {
        v2u w[4][4]; float s[4];
#pragma unroll
        for (int q = 0; q < 4; ++q) { const int r = r0 + q * NGW < M ? r0 + q * NGW : r0; s[q] = lane < 16 ? part[(size_t)r * 16 + lane] : 0.f;
#pragma unroll
            for (int j = 0; j < 4; ++j) w[q][j] = __builtin_nontemporal_load((const v2u*)(XB + (size_t)r * D) + lane + 64 * j); }
#pragma unroll
        for (int q = 0; q < 4; ++q) { const int r = r0 + q * NGW < M ? r0 + q * NGW : r0; const float rs = rsq_eps(wave_sum(s[q]));
#pragma unroll
            for (int j = 0; j < 4; ++j) { const f32x4 v = (f32x4){bf_lo(w[q][j].x), bf_hi(w[q][j].x), bf_lo(w[q][j].y), bf_hi(w[q][j].y)} * g[j] * rs; __builtin_nontemporal_store(v, (f32x4*)(OUT + (size_t)r * D) + lane + 64 * j); } }
    }
}

#define XBAR() do { xcd_barrier(bar); if (REP_BAR) xcd_barrier(bar); } while (0)
#ifndef REP_A
#define REP_A 0
#endif
#ifndef REP_Q
#define REP_Q 0
#endif
#ifndef REP_KV
#define REP_KV 0
#endif
#ifndef REP_SCAN
#define REP_SCAN 0
#endif
#ifndef REP_SGU
#define REP_SGU 0
#endif
#ifndef REP_WIN
#define REP_WIN 0
#endif
#ifndef REP_TAB
#define REP_TAB 0
#endif
#ifndef REP_BAR
#define REP_BAR 0
#endif
#ifndef REP_PREP
#define REP_PREP 0
#endif
#ifndef REP_S5
#define REP_S5 0
#endif
#ifndef REP_ATT
#define REP_ATT 0
#endif
#ifndef REP_RES
#define REP_RES 0
#endif
#define REPEAT(flag_, ...) do { __VA_ARGS__ if (flag_) { __VA_ARGS__ } } while (0)
#ifndef REP_GU
#define REP_GU 0
#endif
#ifndef REP_DOWN
#define REP_DOWN 0
#endif
#define GEMM(EPI, g_, nM_, nN_, nG_, c_, E_) do { pg8::Order S_; S_.init(nM_, nN_, nG_, G, c_); pg8::gemm_phase<EPI, pg8::Order, true, true>(lds, g_, S_, E_); } while (0)
#define GEMM_NA(EPI, g_, nM_, nN_, nG_, c_, E_) do { pg8::Order S_; S_.init(nM_, nN_, nG_, G, c_); pg8::gemm_phase<EPI, pg8::Order, false, true>(lds, g_, S_, E_); } while (0)

__global__ void __launch_bounds__(512, 2) mk_fwd(Args a) {
    extern __shared__ __attribute__((aligned(16))) unsigned char lds_raw[];
    LAS unsigned char* lds = (LAS unsigned char*)lds_raw;
    cg::grid_group grid = cg::this_grid();
    const int tid = threadIdx.x, lane = tid & 63, wave = __builtin_amdgcn_readfirstlane(tid >> 6);
    const int G = gridDim.x, bx = blockIdx.x;
    const int gw = bx * 8 + wave, NGW = G * 8, gt = bx * 512 + tid, NT = G * 512;
    unsigned char* ws = a.ws;
    float* X = a.out;
    bf16* XB = (bf16*)(ws + WS_XB); bf16* H = (bf16*)(ws + WS_H); bf16* QO = (bf16*)(ws + WS_QO); bf16* MEMB = (bf16*)(ws + WS_MEMB); bf16* KB = (bf16*)(ws + WS_KB); bf16* VT = (bf16*)(ws + WS_VT);
    bf16* WKV = (bf16*)(ws + WS_WKV);
#define SSQ(i) ((float*)(ws + ((i) ? WS_SSQ1 : WS_SSQ0)))
    constexpr size_t T1K = (size_t)256 * 1024 * 2;

    volatile LAS unsigned* bst = (volatile LAS unsigned*)(lds + 147392);
    if (tid < 2) bst[tid] = 0u;
    if (bx == 0) for (int i = tid; i < XCD_BAR_WORDS; i += 512) ((unsigned*)ws)[i] = 0u;
    __syncthreads();
    REPEAT(REP_PREP, prep_weights(a, ws, lds, 0, bx, G, tid, 0); prep_misc(a, ws, gw, NGW, gt, NT, lane); __syncthreads(););
    grid.sync();
    XcdBarrier bar = xcd_barrier_post((unsigned*)ws, bst);

    int cur = 0;
#pragma unroll 1
    for (int l = 0; l < 2; ++l) {
#pragma unroll 1
        for (int f = 0; f < 2; ++f) {
            const bf16* WGU = (const bf16*)(ws + (f ? WS_WGU2 : WS_WGU1)); const bf16* WD = (const bf16*)(ws + (f ? WS_WD2 : WS_WD1));
            { pg8::Gemm g{XB, WGU, 1024, 1024, 1024, T1K, 0, 0, T1K, 0, nullptr, 1 << 30}; pg8::EpiSwiGLU E{H, (bf16*)X, SSQ(cur)};
              GEMM(pg8::EpiSwiGLU, g, 192, 32, 1, bx, E);
#if REP_GU
              GEMM(pg8::EpiSwiGLU, g, 192, 32, 1, bx, E);
#endif
            }
            if (f == 0 && l == 1) REPEAT(REP_KV,
                { pg8::Gemm g{MEMB, WKV, 1024, 1024, 1024, T1K, 0, 0, T1K, 0, nullptr, 1 << 30}; pg8::EpiRowScale E{KB, 1024, (const float*)(ws + WS_SSQM)}; GEMM(pg8::EpiRowScale, g, 16, 4, 1, (bx + 64) % G, E); }
                { pg8::Gemm g{WKV + (size_t)1024 * 1024, MEMB, 1024, 1024, 1024, T1K, 0, 0, T1K, 0, nullptr, 1 << 30}; pg8::EpiVT E{VT, (const float*)(ws + WS_RSM)}; GEMM(pg8::EpiVT, g, 4, 16, 1, (bx + 128) % G, E); });
            if (f == 0 && l == 0) REPEAT(REP_TAB, s5_tab2(a, ws, gt, NT););
            if (l == 0 && f == 1) prep_weights(a, ws, lds, 1, bx, G, tid, 1);
            if (l == 1 && f == 0 && bx < G / 2) prep_weights(a, ws, lds, 1, bx, G / 2, tid, 3);
            XBAR();
            { pg8::Gemm g{H, WD, 4096, 4096, 4096, T1K * 4, 0, 0, T1K * 4, 0, (const bf16*)X, 128}; pg8::EpiRes E{XB, SSQ(cur ^ 1), 0.5f};
              GEMM(pg8::EpiRes, g, 192, 4, 1, bx, E);
#if REP_DOWN
              { pg8::EpiRes E2 = E; E2.alpha = 0.f; GEMM(pg8::EpiRes, g, 192, 4, 1, bx, E2); }
#endif
            }
            if (f == 0 && l == 0) REPEAT(REP_TAB, s5_tab3(a, ws, gt, NT););
            if (l == 0 && f == 1) prep_weights(a, ws, lds, 1, bx, G, tid, 2);
            XBAR();
            cur ^= 1;
            if (f == 0) {
                pg8::Gemm gm;
                if (l == 0) {
                    REPEAT(REP_WIN, { pg8::Gemm g{XB, (const bf16*)(ws + WS_WIN), 1024, 1024, 1024, T1K, 0, 0, T1K, 0, nullptr, 1 << 30}; pg8::EpiWin E{(bf16*)(ws + WS_AP), (bf16*)(ws + WS_ZUB), (bf16*)(ws + WS_ZVB), (pg8::f32x2*)(ws + WS_LNP), SSQ(cur)}; GEMM(pg8::EpiWin, g, 192, 6, 1, bx, E); });
                    REPEAT(REP_KV,
                        { pg8::Gemm g{MEMB, WKV, 1024, 1024, 1024, T1K, 0, 0, T1K, 0, nullptr, 1 << 30}; pg8::EpiRowScale E{KB, 1024, (const float*)(ws + WS_SSQM)}; GEMM(pg8::EpiRowScale, g, 16, 4, 1, (bx + 64) % G, E); }
                        { pg8::Gemm g{WKV + (size_t)1024 * 1024, MEMB, 1024, 1024, 1024, T1K, 0, 0, T1K, 0, nullptr, 1 << 30}; pg8::EpiVT E{VT, (const float*)(ws + WS_RSM)}; GEMM(pg8::EpiVT, g, 4, 16, 1, (bx + 128) % G, E); });
                    XBAR();
                    REPEAT(REP_S5, { pg8::Gemm g{(const bf16*)(ws + WS_AP), (const bf16*)(ws + WS_B1S), 768, 512, 512, (size_t)256 * 768 * 2, 0, (size_t)1536 * 768 * 2, 0, (size_t)256 * 512 * 2, nullptr, 1 << 30}; pg8::EpiS5aScan E{(float*)(ws + WS_SST), (bf16*)(ws + WS_AP), (const pg8::f32x2*)(ws + WS_APOW)}; GEMM_NA(pg8::EpiS5aScan, g, 6, 1, 32, bx, E); });
                    sgu_phase(lds, a, ws, 0, 640, (bx + 64) % G, G, tid);
                    XBAR();
                    REPEAT(REP_S5, { pg8::Gemm g{(const bf16*)(ws + WS_AP), (const bf16*)(ws + WS_BT), 768, 768, 768, (size_t)256 * 768 * 2, 0, (size_t)1536 * 768 * 2, (size_t)256 * 768 * 2, (size_t)512 * 768 * 2, nullptr, 1 << 30}; pg8::EpiS5c E{(bf16*)(ws + WS_GB)}; GEMM(pg8::EpiS5c, g, 6, 2, 32, bx, E); });
                    sgu_phase(lds, a, ws, 640, 1152, bx >= G / 2 ? bx - G / 2 : -1, G / 2, tid);
                    XBAR();
                    REPEAT(REP_S5, { pg8::Gemm g{(const bf16*)(ws + WS_GB), (const bf16*)(ws + WS_WGLU), 512, 512, 512, (size_t)256 * 512 * 2, 0, 0, (size_t)256 * 512 * 2, 0, nullptr, 1 << 30}; pg8::EpiGLU E{(const bf16*)(ws + WS_GB), (bf16*)X}; GEMM(pg8::EpiGLU, g, 192, 2, 1, bx, E); });
                    sgu_phase(lds, a, ws, 1152, 1536, bx >= G / 2 ? bx - G / 2 : -1, G / 2, tid);
                    XBAR();
                    gm = pg8::Gemm{(const bf16*)X, (const bf16*)(ws + WS_WOUT), 1024, 1024, 1024, T1K, 0, 0, T1K, 0, nullptr, 1 << 30};
                } else {
                    REPEAT(REP_RES, pool_phase(lds, XB, SSQ(cur), (bf16*)(ws + WS_POOLED), G, bx, tid););
                    XBAR();
                    gm = pg8::Gemm{(const bf16*)(ws + WS_POOLED), (const bf16*)(ws + WS_WPOOL), 1024, 256, 256, T1K, (size_t)256 * 2, 0, (size_t)256 * 256 * 2, 0, nullptr, 1 << 30};
                }
                { pg8::EpiRes E{XB, SSQ(cur ^ 1), 1.0f}; GEMM(pg8::EpiRes, gm, 192, 4, 1, bx, E); if (REP_RES) { E.alpha = 0.f; GEMM(pg8::EpiRes, gm, 192, 4, 1, bx, E); } }
                XBAR();
                cur ^= 1;
                { pg8::Gemm g{XB, (const bf16*)(ws + WS_WQ), 1024, 1024, 1024, T1K, 0, 0, T1K, 0, nullptr, 1 << 30}; pg8::EpiRowScale E{QO, 1024, SSQ(cur)}; REPEAT(REP_Q, GEMM(pg8::EpiRowScale, g, 192, 4, 1, bx, E);); }
                XBAR();
                REPEAT(REP_A, attn_phase(lds, QO, (bf16*)(ws + WS_CAT), KB, VT, G, bx, tid););
                XBAR();
                { pg8::Gemm g{(const bf16*)(ws + WS_CAT), (const bf16*)(ws + WS_WO), 1024, 1024, 1024, T1K, 0, 0, T1K, 0, nullptr, 1 << 30}; pg8::EpiRes E{XB, SSQ(cur ^ 1), 1.0f}; GEMM(pg8::EpiRes, g, 192, 4, 1, bx, E); if (REP_RES) { E.alpha = 0.f; GEMM(pg8::EpiRes, g, 192, 4, 1, bx, E); } }
                XBAR();
                cur ^= 1;
            }
        }
    }
    final_phase(X, XB, SSQ(cur), a.in[35], gw, NGW, lane);
#ifdef REP_FINAL
    final_phase(X, XB, SSQ(cur), a.in[35], gw, NGW, lane);
#endif
}

extern "C" void kernel_launch(void* const* d_in, const int* in_sizes, int n_in, void* d_out, int out_size, void* d_ws, size_t ws_size, hipStream_t stream) {
    static int grid = 0;
    if (grid == 0) {
        if (n_in != 36 || out_size != M * D || ws_size < WS_END) { fprintf(stderr, "kernel_launch: unexpected shapes: n_in %d out %d ws %zu (need %zu)\n", n_in, out_size, ws_size, (size_t)WS_END); grid = -1; return; }
        int dev = 0, cus = 0, per_cu = 0;
        hipGetDevice(&dev);
        hipDeviceGetAttribute(&cus, hipDeviceAttributeMultiprocessorCount, dev);
        hipFuncSetAttribute((const void*)mk_fwd, hipFuncAttributeMaxDynamicSharedMemorySize, LDS_BYTES);
        hipOccupancyMaxActiveBlocksPerMultiprocessor(&per_cu, (const void*)mk_fwd, 512, LDS_BYTES);
        (void)hipGetLastError();
        grid = cus;
        if (grid % 8 != 0 || grid < 8) grid = (grid / 8) * 8;
        fprintf(stderr, "kernel_launch: grid %d (occupancy query: %d per CU), ws %zu\n", grid, per_cu, ws_size);
    }
    if (grid <= 0) return;
    Args a{};
    for (int i = 0; i < 36; ++i) a.in[i] = (const float*)d_in[i];
    a.out = (float*)d_out; a.ws = (unsigned char*)d_ws;
    void* args[] = {&a};
    hipError_t e = hipLaunchCooperativeKernel((const void*)mk_fwd, dim3(grid), dim3(512), args, LDS_BYTES, stream);
    if (e != hipSuccess) fprintf(stderr, "kernel_launch: cooperative launch failed: %s (grid %d)\n", hipGetErrorString(e), grid);
}
```

```cpp
#include <hip/hip_runtime.h>
#include <hip/hip_cooperative_groups.h>
#include <cstdio>
#include <cstdint>
namespace cg = cooperative_groups;

__device__ __forceinline__ int opq(int v) { asm volatile("" : "+v"(v)); return v; }

namespace pg8 {
#define PG8_LAS __attribute__((address_space(3)))
typedef unsigned short bf16_t;
typedef short bf16x8 __attribute__((ext_vector_type(8)));
typedef float f32x4 __attribute__((ext_vector_type(4)));
typedef float f32x2 __attribute__((ext_vector_type(2)));
typedef unsigned u32x4 __attribute__((ext_vector_type(4)));
typedef unsigned u32x2 __attribute__((ext_vector_type(2)));
constexpr int BM = 256, BK = 64, HALF = 128, HTB = HALF * BK * 2  , STAGE_BYTES = 8 * HTB, NXCD = 8, WGM = 8;

__host__ __device__ __forceinline__ int lds_byte(int r, int c) { const int st = (r >> 4) * 2 + (c >> 5), rr = r & 15, cc = c & 31, ob = rr * 64 + cc * 2; return st * 1024 + (ob ^ (((ob >> 9) & 1) << 5)); }
__host__ __device__ __forceinline__ void stage_rc(int b, int& R, int& C) { const int st = b / 1024, sb = b % 1024, swz = sb ^ (((sb >> 9) & 1) << 5); R = (st >> 1) * 16 + swz / 64; C = (st & 1) * 32 + (swz % 64) / 2; }
__host__ __device__ __forceinline__ int perm32(int rho) { const int n = rho >> 4, i = rho & 15; return 8 * (i >> 2) + 4 * n + (i & 3); }

struct Unit { int pm, pn, g; };
struct Gemm { const bf16_t* A; const bf16_t* Bt; int lda, ldb, K; size_t a_pm, a_pn, a_g, b_pn, b_g; const bf16_t* A2; int pm2; };

struct Order {
    int nM, nN, nwg, tot, G, c;
    __device__ __forceinline__ void init(int nM_, int nN_, int nG_, int G_, int c_) { nM = nM_; nN = nN_; nwg = nM_ * nN_; tot = nwg * nG_; G = G_; c = c_; }
    __device__ __forceinline__ bool next(int i, Unit& u) const {
        const int L = i * G + c; if (L >= tot) return false;
        if (tot == nwg) {
            int wgid = L; { const int q = nwg / NXCD, r = nwg % NXCD, xcd = wgid % NXCD, off = wgid / NXCD; wgid = (xcd < r ? xcd * (q + 1) : r * (q + 1) + (xcd - r) * q) + off; }
            const int nig = WGM * nN, gid = wgid / nig, fm = gid * WGM, gsz = (nM - fm) < WGM ? (nM - fm) : WGM;
            u.pm = fm + ((wgid % nig) % gsz); u.pn = (wgid % nig) / gsz; u.g = 0;
        } else { u.g = L / nwg; const int r = L % nwg; u.pm = r / nN; u.pn = r % nN; }
        return true;
    }
    __device__ __forceinline__ void a_ready(const Unit&) const {}
    __device__ __forceinline__ void done(const Unit&) const {}
};

typedef __bf16 bf16x2_t __attribute__((ext_vector_type(2)));
__device__ __forceinline__ unsigned cvt_pk_bf16(float lo, float hi) { const f32x2 v = {lo, hi}; const bf16x2_t b = __builtin_convertvector(v, bf16x2_t); return __builtin_bit_cast(unsigned, b); }
__device__ __forceinline__ u32x4 pack8(const f32x4 a, const f32x4 b) { u32x4 w; w.x = cvt_pk_bf16(a[0], a[1]); w.y = cvt_pk_bf16(a[2], a[3]); w.z = cvt_pk_bf16(b[0], b[1]); w.w = cvt_pk_bf16(b[2], b[3]); return w; }
__device__ __forceinline__ float bf_lo(unsigned w) { return __uint_as_float(w << 16); }
__device__ __forceinline__ float bf_hi(unsigned w) { return __uint_as_float(w & 0xffff0000u); }
__device__ __forceinline__ float sigm(float x) { return __builtin_amdgcn_rcpf(1.0f + __builtin_amdgcn_exp2f(-1.4426950408889634f * x)); }
__device__ __forceinline__ float silu_f(float x) { return x * sigm(x); }
__device__ __forceinline__ float gelu_t(float x) { return x * sigm(1.5957691216057308f * (x + 0.044715f * x * x * x)); }
__device__ __forceinline__ f32x4 gelu4(const f32x4 x) { f32x4 t = (x * x * 0.044715f + 1.0f) * x * (-1.5957691216057308f * 1.4426950408889634f);
    _Pragma("unroll") for (int e = 0; e < 4; ++e) t[e] = __builtin_amdgcn_exp2f(t[e]);
    t += 1.0f;
    _Pragma("unroll") for (int e = 0; e < 4; ++e) t[e] = __builtin_amdgcn_rcpf(t[e]);
    return x * t; }
__device__ __forceinline__ float fq_sum(float v) {
    auto r16 = __builtin_amdgcn_permlane16_swap(__float_as_uint(v), __float_as_uint(v), false, false); v = __uint_as_float(r16[0]) + __uint_as_float(r16[1]);
    auto r32 = __builtin_amdgcn_permlane32_swap(__float_as_uint(v), __float_as_uint(v), false, false); return __uint_as_float(r32[0]) + __uint_as_float(r32[1]); }
__device__ __forceinline__ float row_rs16(const float* part, int row, int fq) {
    const f32x4 v = *(const f32x4*)(part + (size_t)row * 16 + fq * 4);
    float s = (v[0] + v[1]) + (v[2] + v[3]); s += __shfl_xor(s, 16); s += __shfl_xor(s, 32);
    return __builtin_amdgcn_rsqf(s * (1.0f / 1024.0f) + 1e-6f);
}
#define EPI_ROWS(...) _Pragma("unroll") for (int ai = 0; ai < 2; ++ai) _Pragma("unroll") for (int m = 0; m < 4; ++m) { const int row = u.pm * BM + ai * HALF + wr * 64 + m * 16 + fr; __VA_ARGS__ }

#define EPI_RS8(part_) float rsv[2][4]; { f32x4 pq_[2][4]; \
    _Pragma("unroll") for (int ai = 0; ai < 2; ++ai) _Pragma("unroll") for (int m = 0; m < 4; ++m) pq_[ai][m] = *(const f32x4*)((part_) + (size_t)(u.pm * BM + ai * HALF + wr * 64 + m * 16 + fr) * 16 + fq * 4); \
    _Pragma("unroll") for (int ai = 0; ai < 2; ++ai) _Pragma("unroll") for (int m = 0; m < 4; ++m) rsv[ai][m] = (pq_[ai][m][0] + pq_[ai][m][1]) + (pq_[ai][m][2] + pq_[ai][m][3]); \
    _Pragma("unroll") for (int ai = 0; ai < 2; ++ai) _Pragma("unroll") for (int m = 0; m < 4; ++m) rsv[ai][m] = fq_sum(rsv[ai][m]); \
    _Pragma("unroll") for (int ai = 0; ai < 2; ++ai) _Pragma("unroll") for (int m = 0; m < 4; ++m) rsv[ai][m] = __builtin_amdgcn_rsqf(rsv[ai][m] * (1.0f / 1024.0f) + 1e-6f); }
struct EpiSwiGLU {
    static constexpr bool PERM = true, AFTER_DRAIN = false;
    bf16_t* H; bf16_t* H2; const float* part;
    __device__ __forceinline__ void operator()(const f32x4 (&acc)[2][2][4][2], const Unit& u, int wr, int wc, int fr, int fq) const {
        const int col = u.pn * HALF + wc * 32 + fq * 8;
        bf16_t* hb = u.pm < 128 ? H : H2 - (size_t)32768 * 4096;
        EPI_RS8(part)
        EPI_ROWS(
            const float rs = rsv[ai][m];
            const f32x4 g0 = acc[ai][0][m][0] * rs, g1 = acc[ai][0][m][1] * rs, u0 = acc[ai][1][m][0] * rs, u1 = acc[ai][1][m][1] * rs;
            f32x4 e0 = g0 * -1.4426950408889634f, e1 = g1 * -1.4426950408889634f;
            _Pragma("unroll") for (int e = 0; e < 4; ++e) { e0[e] = __builtin_amdgcn_exp2f(e0[e]); e1[e] = __builtin_amdgcn_exp2f(e1[e]); }
            e0 += 1.0f; e1 += 1.0f;
            _Pragma("unroll") for (int e = 0; e < 4; ++e) { e0[e] = __builtin_amdgcn_rcpf(e0[e]); e1[e] = __builtin_amdgcn_rcpf(e1[e]); }
            const f32x4 h0 = (g0 * u0) * e0, h1 = (g1 * u1) * e1;
            __builtin_nontemporal_store(pack8(h0, h1), (u32x4*)(hb + (size_t)row * 4096 + col));
        )
    }
};
struct EpiRes {
    static constexpr bool PERM = true, AFTER_DRAIN = false;
    bf16_t* xb; float* part_out; float alpha;
    __device__ __forceinline__ void operator()(const f32x4 (&acc)[2][2][4][2], const Unit& u, int wr, int wc, int fr, int fq) const {
        const int col0 = u.pn * BM + wc * 32 + fq * 8;
#pragma unroll
        for (int ai = 0; ai < 2; ++ai) {
            u32x4 xv[4][2];
#pragma unroll
            for (int m = 0; m < 4; ++m)
#pragma unroll
                for (int bj = 0; bj < 2; ++bj) xv[m][bj] = *(const u32x4*)(xb + (size_t)(u.pm * BM + ai * HALF + wr * 64 + m * 16 + fr) * 1024 + col0 + bj * HALF);
#pragma unroll
            for (int m = 0; m < 4; ++m) {
                const int row = u.pm * BM + ai * HALF + wr * 64 + m * 16 + fr;
                float ss = 0.f;
#pragma unroll
                for (int bj = 0; bj < 2; ++bj) {
                    const u32x4 w = xv[m][bj];
                    f32x4 v0 = (f32x4){bf_lo(w.x), bf_hi(w.x), bf_lo(w.y), bf_hi(w.y)}; f32x4 v1 = (f32x4){bf_lo(w.z), bf_hi(w.z), bf_lo(w.w), bf_hi(w.w)};
                    v0 += acc[ai][bj][m][0] * alpha; v1 += acc[ai][bj][m][1] * alpha;
                    ss += (v0[0] * v0[0] + v0[1] * v0[1]) + (v0[2] * v0[2] + v0[3] * v0[3]) + (v1[0] * v1[0] + v1[1] * v1[1]) + (v1[2] * v1[2] + v1[3] * v1[3]);
                    *(u32x4*)(xb + (size_t)row * 1024 + col0 + bj * HALF) = pack8(v0, v1);
                }
                ss = fq_sum(ss);
                if (fq == 0) part_out[(size_t)row * 16 + u.pn * 4 + wc] = ss;
            }
            asm volatile("" ::: "memory");
        }
    }
};
struct EpiRowScale {
    static constexpr bool PERM = true, AFTER_DRAIN = false;
    bf16_t* O; int ldc; const float* part;
    __device__ __forceinline__ void operator()(const f32x4 (&acc)[2][2][4][2], const Unit& u, int wr, int wc, int fr, int fq) const {
        const int col0 = u.pn * BM + wc * 32 + fq * 8;
        EPI_RS8(part)
        EPI_ROWS(
            const float rs = rsv[ai][m];
            _Pragma("unroll") for (int bj = 0; bj < 2; ++bj) *(u32x4*)(O + (size_t)row * ldc + col0 + bj * HALF) = pack8(acc[ai][bj][m][0] * rs, acc[ai][bj][m][1] * rs);
        )
    }
};
struct EpiVT {
    static constexpr bool PERM = true, AFTER_DRAIN = false;
    bf16_t* O; const float* rsm;
    __device__ __forceinline__ void operator()(const f32x4 (&acc)[2][2][4][2], const Unit& u, int wr, int wc, int fr, int fq) const {
        const int col0 = u.pn * BM + wc * 32 + fq * 8;
        f32x4 s[2][2];
        _Pragma("unroll") for (int bj = 0; bj < 2; ++bj) { s[bj][0] = *(const f32x4*)(rsm + col0 + bj * HALF); s[bj][1] = *(const f32x4*)(rsm + col0 + bj * HALF + 4); }
        EPI_ROWS(
            _Pragma("unroll") for (int bj = 0; bj < 2; ++bj) *(u32x4*)(O + (size_t)row * 4096 + col0 + bj * HALF) = pack8(acc[ai][bj][m][0] * s[bj][0], acc[ai][bj][m][1] * s[bj][1]);
        )
    }
};
struct EpiWin {
    static constexpr bool PERM = true, AFTER_DRAIN = false;
    bf16_t* AP; bf16_t* ZUB; bf16_t* ZVB; f32x2* lnp; const float* part;
    __device__ __forceinline__ void operator()(const f32x4 (&acc)[2][2][4][2], const Unit& u, int wr, int wc, int fr, int fq) const {
        const int cl = wc * 32 + fq * 8;
        EPI_RS8(part)
        EPI_ROWS(
            const float rs = rsv[ai][m];
            if (u.pn < 2) {
                _Pragma("unroll") for (int bj = 0; bj < 2; ++bj) { const int c = u.pn * BM + bj * HALF + cl; const int g = c >> 4;
                    *(u32x4*)(AP + ((size_t)(g * 1536 + (row >> 5)) * 768 + (row & 31) * 16 + (c & 15))) = pack8(acc[ai][bj][m][0] * rs, acc[ai][bj][m][1] * rs); }
            } else if (u.pn < 4) {
                _Pragma("unroll") for (int bj = 0; bj < 2; ++bj) { const int c = (u.pn - 2) * BM + bj * HALF + cl; f32x4 a = acc[ai][bj][m][0] * rs, b = acc[ai][bj][m][1] * rs;
                    a = gelu4(a); b = gelu4(b);
                    *(u32x4*)(ZUB + (size_t)row * 512 + c) = pack8(a, b); }
            } else {
                float s1 = 0.f, s2 = 0.f;
                _Pragma("unroll") for (int bj = 0; bj < 2; ++bj) { const int c = (u.pn - 4) * BM + bj * HALF + cl; f32x4 a = acc[ai][bj][m][0] * rs, b = acc[ai][bj][m][1] * rs;
                    a = gelu4(a); b = gelu4(b); _Pragma("unroll") for (int e = 0; e < 4; ++e) { s1 += a[e] + b[e]; s2 += a[e] * a[e] + b[e] * b[e]; }
                    *(u32x4*)(ZVB + (size_t)row * 512 + c) = pack8(a, b); }
                s1 = fq_sum(s1); s2 = fq_sum(s2);
                if (fq == 0) lnp[(size_t)row * 8 + (u.pn - 4) * 4 + wc] = (f32x2){s1, s2};
            }
        )
    }
};
struct EpiF32 {
    static constexpr bool PERM = true, AFTER_DRAIN = false;
    float* O; int ldc; int rows_per_g;
    __device__ __forceinline__ void operator()(const f32x4 (&acc)[2][2][4][2], const Unit& u, int wr, int wc, int fr, int fq) const {
        const int col0 = u.pn * BM + wc * 32 + fq * 8;
        EPI_ROWS(
            _Pragma("unroll") for (int bj = 0; bj < 2; ++bj) { float* p = O + ((size_t)u.g * rows_per_g + row) * ldc + col0 + bj * HALF; *(f32x4*)p = acc[ai][bj][m][0]; *(f32x4*)(p + 4) = acc[ai][bj][m][1]; }
        )
    }
};
struct EpiS5aScan {
    static constexpr bool PERM = true, AFTER_DRAIN = true;
    float* SST; bf16_t* AP; const f32x2* APOW;
    __device__ __forceinline__ void fused(f32x4 (&acc)[2][2][4][2], const Unit& u, int wr, int wc, int fr, int fq, PG8_LAS unsigned char* lds, int wid, int lane) const {
        const int col0 = wc * 32 + fq * 8;
        EPI_ROWS(
            _Pragma("unroll") for (int bj = 0; bj < 2; ++bj) { float* p = SST + ((size_t)u.g * 1536 + row) * 256 + col0 + bj * HALF; *(f32x4*)p = acc[ai][bj][m][0]; *(f32x4*)(p + 4) = acc[ai][bj][m][1]; }
        )
        asm volatile("s_waitcnt vmcnt(0)" ::: "memory"); __builtin_amdgcn_s_barrier(); asm volatile("" ::: "memory");
        const int tid = wid * 64 + lane, p = tid & 63, dir = (tid >> 6) & 1, sl = tid >> 7;
        const bool prompt = u.pm < 4; const int nch = prompt ? 128 : 64, ch0 = u.pm * 256 + sl * nch;
        if (prompt && sl >= 2) return;
        const f32x2 a32 = APOW[((size_t)(dir * 32 + u.g) * 33 + 32) * 64 + p];
        const float* S = SST + (size_t)u.g * 1536 * 256 + dir * 128 + p; bf16_t* H = AP + (size_t)u.g * 1536 * 768 + 512 + dir * 128 + p;
        float hr = 0.f, hi = 0.f;
#pragma unroll 8
        for (int i = 0; i < nch; ++i) {
            const int ch = ch0 + (dir == 0 ? i : nch - 1 - i);
            const float sr = S[(size_t)ch * 256], si = S[(size_t)ch * 256 + 64];
            H[(size_t)ch * 768] = (bf16_t)(cvt_pk_bf16(hr, 0.f) & 0xffffu); H[(size_t)ch * 768 + 64] = (bf16_t)(cvt_pk_bf16(hi, 0.f) & 0xffffu);
            const float nr = a32.x * hr - a32.y * hi + sr, ni = a32.x * hi + a32.y * hr + si; hr = nr; hi = ni;
        }
    }
};
struct EpiS5c {
    static constexpr bool PERM = true, AFTER_DRAIN = false;
    bf16_t* G;
    __device__ __forceinline__ void operator()(const f32x4 (&acc)[2][2][4][2], const Unit& u, int wr, int wc, int fr, int fq) const {
        const int col0 = u.pn * BM + wc * 32 + fq * 8;
        EPI_ROWS(
            _Pragma("unroll") for (int bj = 0; bj < 2; ++bj) { const int col = col0 + bj * HALF; const int t = col >> 4, c = col & 15; f32x4 a = acc[ai][bj][m][0], b = acc[ai][bj][m][1];
                a = gelu4(a); b = gelu4(b);
                *(u32x4*)(G + ((size_t)(row * 32 + t) * 512 + u.g * 16 + c)) = pack8(a, b); }
        )
    }
};
struct EpiGLU {
    static constexpr bool PERM = true, AFTER_DRAIN = false;
    const bf16_t* G; bf16_t* CAT;
    __device__ __forceinline__ void operator()(const f32x4 (&acc)[2][2][4][2], const Unit& u, int wr, int wc, int fr, int fq) const {
        const int col0 = u.pn * BM + wc * 32 + fq * 8;
        EPI_ROWS(
            _Pragma("unroll") for (int bj = 0; bj < 2; ++bj) { const int col = col0 + bj * HALF; const u32x4 gv = *(const u32x4*)(G + (size_t)row * 512 + col);
                f32x4 a, b; a[0] = bf_lo(gv.x) * sigm(acc[ai][bj][m][0][0]); a[1] = bf_hi(gv.x) * sigm(acc[ai][bj][m][0][1]); a[2] = bf_lo(gv.y) * sigm(acc[ai][bj][m][0][2]); a[3] = bf_hi(gv.y) * sigm(acc[ai][bj][m][0][3]);
                b[0] = bf_lo(gv.z) * sigm(acc[ai][bj][m][1][0]); b[1] = bf_hi(gv.z) * sigm(acc[ai][bj][m][1][1]); b[2] = bf_lo(gv.w) * sigm(acc[ai][bj][m][1][2]); b[3] = bf_hi(gv.w) * sigm(acc[ai][bj][m][1][3]);
                *(u32x4*)(CAT + (size_t)row * 1024 + col) = pack8(a, b); }
        )
    }
};

template <class Epi, class Sched, bool ALIGN_EPI = false, bool SP2 = false>
__device__ __forceinline__ void gemm_phase(PG8_LAS unsigned char* lds, const Gemm g, const Sched& S, const Epi& E) {
    const int tid = opq((int)threadIdx.x), wid = __builtin_amdgcn_readfirstlane(tid >> 6), lane = tid & 63, wr = wid >> 2, wc = wid & 3, fr = lane & 15, fq = lane >> 4;
    const int K = g.K, nt = K / BK, lda = g.lda, ldb = g.ldb;
    unsigned voffA[2], voffB[2];
#pragma unroll
    for (int i = 0; i < 2; ++i) { int R, C; stage_rc(tid * 16 + i * 8192, R, C); const int Rb = Epi::PERM ? ((R & ~31) + perm32(R & 31)) : R;
        voffA[i] = (unsigned)(R * lda + C) * 2u; voffB[i] = (unsigned)(Rb * ldb + C) * 2u; }
    const size_t kstep = (size_t)(BK * 2);
    const size_t hstepA = (size_t)HALF * lda * 2, hstepB = (size_t)HALF * ldb * 2;
    const unsigned ldsw = (unsigned)wid * 1024u;
    const int aoff = lds_byte(wr * 64 + fr, fq * 8), boff = lds_byte(wc * 32 + fr, fq * 8);
#define PG8_SA(b, h) (((b) * 2 + (h)) * HTB)
#define PG8_SB(b, h) ((4 + (b) * 2 + (h)) * HTB)
#define PG8_STAGE(bufoff, gbase, voff) do { _Pragma("unroll") for (int _i = 0; _i < 2; ++_i) \
        __builtin_amdgcn_global_load_lds((const unsigned*)((const char*)(gbase) + (voff)[_i]), (PG8_LAS unsigned*)(lds + (bufoff) + ldsw + _i * 8192), 16, 0, 0); } while (0)
#define PG8_LDA(dst, b, h) do { _Pragma("unroll") for (int m = 0; m < 4; ++m) _Pragma("unroll") for (int k = 0; k < 2; ++k) dst[m][k] = *(const PG8_LAS bf16x8*)(lds + PG8_SA(b, h) + aoff + m * 2048 + k * 1024); } while (0)
#define PG8_LDB(dst, b, h) do { _Pragma("unroll") for (int n = 0; n < 2; ++n) _Pragma("unroll") for (int k = 0; k < 2; ++k) dst[n][k] = *(const PG8_LAS bf16x8*)(lds + PG8_SB(b, h) + boff + n * 2048 + k * 1024); } while (0)
#define PG8_MMA(ai, bj, At, Bt) do { __builtin_amdgcn_s_setprio(1); _Pragma("unroll") for (int m = 0; m < 4; ++m) _Pragma("unroll") for (int n = 0; n < 2; ++n) _Pragma("unroll") for (int k = 0; k < 2; ++k) \
        acc[ai][bj][m][n] = __builtin_amdgcn_mfma_f32_16x16x32_bf16(Bt[n][k], At[m][k], acc[ai][bj][m][n], 0, 0, 0); __builtin_amdgcn_s_setprio(0); } while (0)
#define PG8_WAIT_V(n) asm volatile("s_waitcnt vmcnt(" #n ")" ::: "memory")
#define PG8_WAIT_L(n) asm volatile("s_waitcnt lgkmcnt(" #n ")" ::: "memory")
#define PG8_BAR __builtin_amdgcn_s_barrier()
#define PG8_SCHED __builtin_amdgcn_sched_barrier(0)
    Unit cur, nxt; int ui = 0;
    if (!S.next(0, cur)) return;
    f32x4 acc[2][2][4][2];
#pragma unroll
    for (int a = 0; a < 2; ++a)
#pragma unroll
        for (int b = 0; b < 2; ++b)
#pragma unroll
            for (int m = 0; m < 4; ++m)
#pragma unroll
                for (int n = 0; n < 2; ++n) acc[a][b][m][n] = (f32x4){0.f, 0.f, 0.f, 0.f};
    bf16x8 At[4][2], B0[2][2], B1[2][2];
    const char* cA = (cur.pm < g.pm2 ? (const char*)g.A + (size_t)cur.pm * g.a_pm : (const char*)g.A2 + (size_t)(cur.pm - g.pm2) * g.a_pm) + (size_t)cur.pn * g.a_pn + (size_t)cur.g * g.a_g; const char* cB = (const char*)g.Bt + (size_t)cur.pn * g.b_pn + (size_t)cur.g * g.b_g;
    S.a_ready(cur);
    if constexpr (SP2) {
        PG8_STAGE(PG8_SB(0, 0), cB, voffB); PG8_STAGE(PG8_SB(0, 1), cB + hstepB, voffB); PG8_STAGE(PG8_SA(0, 0), cA, voffA); PG8_STAGE(PG8_SA(0, 1), cA + hstepA, voffA);
        if (wr == 1) PG8_BAR;
        PG8_WAIT_V(2); PG8_BAR;
        PG8_STAGE(PG8_SB(1, 0), cB + kstep, voffB); PG8_STAGE(PG8_SA(1, 0), cA + kstep, voffA); PG8_STAGE(PG8_SB(1, 1), cB + hstepB + kstep, voffB);
        PG8_WAIT_V(6); PG8_BAR;
    } else {
        PG8_STAGE(PG8_SB(0, 0), cB, voffB); PG8_STAGE(PG8_SA(0, 0), cA, voffA); PG8_STAGE(PG8_SB(0, 1), cB + hstepB, voffB); PG8_STAGE(PG8_SA(0, 1), cA + hstepA, voffA);
        if (wr == 1) PG8_BAR;
        PG8_WAIT_V(4); PG8_BAR;
        PG8_STAGE(PG8_SB(1, 0), cB + kstep, voffB); PG8_STAGE(PG8_SA(1, 0), cA + kstep, voffA); PG8_STAGE(PG8_SB(1, 1), cB + hstepB + kstep, voffB);
        PG8_WAIT_V(6); PG8_BAR;
    }
    for (;;) {
        const bool has_next = S.next(ui + 1, nxt);
        const char* nA = has_next ? (nxt.pm < g.pm2 ? (const char*)g.A + (size_t)nxt.pm * g.a_pm : (const char*)g.A2 + (size_t)(nxt.pm - g.pm2) * g.a_pm) + (size_t)nxt.pn * g.a_pn + (size_t)nxt.g * g.a_g : cA; const char* nB = has_next ? (const char*)g.Bt + (size_t)nxt.pn * g.b_pn + (size_t)nxt.g * g.b_g : cB;
        for (int t = 0; t < nt; t += 2) {
            const bool last = (t == nt - 2);
            const char* a1 = cA + (size_t)(t + 1) * kstep;
            const char* a2 = last ? nA : cA + (size_t)(t + 2) * kstep; const char* b2 = last ? nB : cB + (size_t)(t + 2) * kstep;
            const char* a3 = a2 + kstep; const char* b3 = b2 + kstep;
            if (last && has_next) S.a_ready(nxt);
            if constexpr (SP2) {
            PG8_LDB(B0, 0, 0); PG8_LDB(B1, 0, 1); PG8_SCHED; PG8_LDA(At, 0, 0); PG8_STAGE(PG8_SA(1, 1), a1 + hstepA, voffA);
            PG8_WAIT_V(8); PG8_WAIT_L(0); PG8_BAR; PG8_MMA(0, 0, At, B0); PG8_MMA(0, 1, At, B1); PG8_BAR; PG8_SCHED;
            PG8_LDA(At, 0, 1); PG8_STAGE(PG8_SB(0, 0), b2, voffB); PG8_STAGE(PG8_SB(0, 1), b2 + hstepB, voffB); PG8_STAGE(PG8_SA(0, 0), a2, voffA);
            PG8_WAIT_V(8); PG8_WAIT_L(0); PG8_BAR; PG8_MMA(1, 0, At, B0); PG8_MMA(1, 1, At, B1); PG8_BAR; PG8_SCHED;
            PG8_LDB(B0, 1, 0); PG8_LDB(B1, 1, 1); PG8_SCHED; PG8_LDA(At, 1, 0); PG8_STAGE(PG8_SA(0, 1), a2 + hstepA, voffA);
            PG8_WAIT_V(8); PG8_WAIT_L(0); PG8_BAR; PG8_MMA(0, 0, At, B0); PG8_MMA(0, 1, At, B1); PG8_BAR; PG8_SCHED;
            PG8_LDA(At, 1, 1); PG8_STAGE(PG8_SB(1, 0), b3, voffB); PG8_STAGE(PG8_SB(1, 1), b3 + hstepB, voffB); PG8_STAGE(PG8_SA(1, 0), a3, voffA);
            PG8_WAIT_V(8); PG8_WAIT_L(0); PG8_BAR; PG8_MMA(1, 0, At, B0); PG8_MMA(1, 1, At, B1); PG8_BAR; PG8_SCHED;
            } else {
            PG8_LDB(B0, 0, 0); PG8_SCHED; PG8_LDA(At, 0, 0); PG8_STAGE(PG8_SA(1, 1), a1 + hstepA, voffA);
            PG8_WAIT_L(8); PG8_BAR; PG8_WAIT_L(0); PG8_MMA(0, 0, At, B0); PG8_BAR; PG8_SCHED;
            PG8_LDB(B1, 0, 1); PG8_STAGE(PG8_SB(0, 0), b2, voffB);
            PG8_BAR; PG8_WAIT_L(0); PG8_MMA(0, 1, At, B1); PG8_BAR;
            PG8_LDA(At, 0, 1); PG8_STAGE(PG8_SA(0, 0), a2, voffA);
            PG8_BAR; PG8_WAIT_L(0); PG8_MMA(1, 0, At, B0); PG8_BAR; PG8_SCHED;
            PG8_STAGE(PG8_SB(0, 1), b2 + hstepB, voffB);
            PG8_WAIT_V(6); PG8_BAR; PG8_MMA(1, 1, At, B1); PG8_BAR;
            PG8_LDB(B0, 1, 0); PG8_SCHED; PG8_LDA(At, 1, 0); PG8_STAGE(PG8_SA(0, 1), a2 + hstepA, voffA);
            PG8_WAIT_L(8); PG8_BAR; PG8_WAIT_L(0); PG8_MMA(0, 0, At, B0); PG8_BAR; PG8_SCHED;
            PG8_LDB(B1, 1, 1); PG8_STAGE(PG8_SB(1, 0), b3, voffB);
            PG8_BAR; PG8_WAIT_L(0); PG8_MMA(0, 1, At, B1); PG8_BAR;
            PG8_LDA(At, 1, 1); PG8_STAGE(PG8_SA(1, 0), a3, voffA);
            PG8_BAR; PG8_WAIT_L(0); PG8_MMA(1, 0, At, B0); PG8_BAR; PG8_SCHED;
            PG8_STAGE(PG8_SB(1, 1), b3 + hstepB, voffB);
            PG8_WAIT_V(6); PG8_BAR; PG8_MMA(1, 1, At, B1); PG8_BAR;
            }
        }
        if constexpr (ALIGN_EPI) { if (wr == 0) PG8_BAR; }
        if constexpr (!Epi::AFTER_DRAIN) { E(acc, cur, wr, wc, fr, fq); S.done(cur); }
        if (!has_next) break;
#pragma unroll
        for (int a = 0; a < 2; ++a)
#pragma unroll
            for (int b = 0; b < 2; ++b)
#pragma unroll
                for (int m = 0; m < 4; ++m)
#pragma unroll
                    for (int n = 0; n < 2; ++n) acc[a][b][m][n] = (f32x4){0.f, 0.f, 0.f, 0.f};
        cur = nxt; cA = nA; cB = nB; ++ui;
        if constexpr (ALIGN_EPI) { if (wr == 1) PG8_BAR; }
    }
    PG8_WAIT_V(0);
    if constexpr (!ALIGN_EPI) { if (wr == 0) PG8_BAR; }
    PG8_BAR;
    if constexpr (Epi::AFTER_DRAIN) { E.fused(acc, cur, wr, wc, fr, fq, lds, wid, lane); S.done(cur); }
#undef PG8_SA
#undef PG8_SB
#undef PG8_STAGE
#undef PG8_LDA
#undef PG8_LDB
#undef PG8_MMA
#undef PG8_WAIT_V
#undef PG8_WAIT_L
#undef PG8_BAR
#undef PG8_SCHED
}
}

#define LAS __attribute__((address_space(3)))
typedef unsigned short bf16;
typedef unsigned v4u __attribute__((ext_vector_type(4)));
typedef unsigned v2u __attribute__((ext_vector_type(2)));
typedef float f32x4 __attribute__((ext_vector_type(4)));
typedef float f32x2 __attribute__((ext_vector_type(2)));
typedef short bf16x8 __attribute__((ext_vector_type(8)));
using pg8::cvt_pk_bf16; using pg8::bf_lo; using pg8::bf_hi;

constexpr int M = 49152, D = 1024, FF = 4096, NSPLIT = 3, SROWS = M / NSPLIT;
constexpr int LDS_BYTES = 147456;
constexpr size_t MiB = (size_t)1 << 20;
constexpr size_t WS_SSQ0 = 1 * MiB, WS_SSQ1 = 4 * MiB, WS_LNP = 7 * MiB, WS_RSM = 10 * MiB, WS_SSQM = 10 * MiB + 256 * 1024, WS_APOW = 11 * MiB, WS_BBAR = 13 * MiB, WS_WSB = 13 * MiB + 512 * 1024, WS_KTAB = 14 * MiB;
constexpr size_t WS_WGU1 = 16 * MiB, WS_WGU2 = 32 * MiB, WS_WD1 = 48 * MiB, WS_WD2 = 56 * MiB, WS_WQ = 64 * MiB, WS_WKV = 66 * MiB, WS_WO = 70 * MiB, WS_WIN = 72 * MiB, WS_WGLU = 75 * MiB, WS_WOUT = 76 * MiB, WS_WPOOL = 78 * MiB;
constexpr size_t WS_XB = 88 * MiB, WS_MEMB = 184 * MiB, WS_KB = 192 * MiB, WS_VT = 200 * MiB;
constexpr size_t WS_H = 208 * MiB, WS_QO = 208 * MiB, WS_POOLED = 208 * MiB, WS_ZUB = 208 * MiB, WS_ZVB = 256 * MiB, WS_SST = 304 * MiB, WS_GB = 352 * MiB, WS_AP = 400 * MiB, WS_BT = 472 * MiB, WS_B1S = 496 * MiB, WS_CAT = 400 * MiB, WS_END = 504 * MiB;

struct Args { const float* in[36]; float* out; unsigned char* ws; };

#define LDS_WAIT() asm volatile("s_waitcnt lgkmcnt(0)" ::: "memory")
__device__ __forceinline__ float wave_sum(float v) {
#pragma unroll
    for (int o = 1; o < 64; o <<= 1) v += __shfl_xor(v, o);
    return v;
}
__device__ __forceinline__ unsigned short f2bf(float f) { return (unsigned short)(cvt_pk_bf16(f, 0.f) & 0xffffu); }
__device__ __forceinline__ float rsq_eps(float ssq) { return __builtin_amdgcn_rsqf(ssq * (1.0f / 1024.0f) + 1e-6f); }

struct TD { const float* W; const float* gk; const float* gn; bf16* WT; int ldw, k0, n0, ldt, drow_off, mode; float scale; };
__device__ __forceinline__ void td_load(const TD& d, int tid, f32x4 (&v)[8]) {
#pragma unroll
    for (int i = 0; i < 8; ++i) { const int idx = tid + 512 * i, kk = idx >> 6, c4 = idx & 63; v[i] = __builtin_nontemporal_load((const f32x4*)(d.W + (size_t)(d.k0 + kk) * d.ldw + d.n0 + c4 * 4)); }
}
__device__ __forceinline__ void td_store(const TD& d, int tid, const f32x4 (&v)[8], LAS float* scr) {
#pragma unroll
    for (int i = 0; i < 8; ++i) { const int idx = tid + 512 * i, kk = idx >> 6, c4 = idx & 63; const float g = d.gk ? d.gk[d.k0 + kk] : 1.0f;
#pragma unroll
        for (int e = 0; e < 4; ++e) { const int n = c4 * 4 + e; scr[kk * 257 + (n ^ ((n >> 5) & 3))] = v[i][e] * g; } }
    __syncthreads();
#pragma unroll
    for (int j = 0; j < 4; ++j) {
        const int n = (tid >> 2) + 128 * (j >> 1), c = (tid & 3) + 4 * (j & 1), ng = d.n0 + n; const float sc = d.gn ? d.scale * d.gn[ng] : d.scale;
        const LAS float* s = scr + (8 * c) * 257 + (n ^ ((n >> 5) & 3));
        v4u o; o.x = cvt_pk_bf16(s[0 * 257] * sc, s[1 * 257] * sc); o.y = cvt_pk_bf16(s[2 * 257] * sc, s[3 * 257] * sc); o.z = cvt_pk_bf16(s[4 * 257] * sc, s[5 * 257] * sc); o.w = cvt_pk_bf16(s[6 * 257] * sc, s[7 * 257] * sc);
        const int drow = d.mode == 0 ? ng : ((ng >> 7) * 256 + (ng & 127) + (d.mode == 2 ? 128 : 0));
        *(v4u*)(d.WT + (size_t)(d.drow_off + drow) * d.ldt + d.k0 + 8 * c) = o;
    }
    __syncthreads();
}
#define TDS(W_, K_, N_, GK_, SC_, WT_, MODE_) { constexpr int nblk_ = (N_) / 256, cnt_ = ((K_) / 64) * nblk_; if (r < cnt_) { d.W = (W_); d.ldw = (N_); d.k0 = 64 * (r / nblk_); d.n0 = 256 * (r % nblk_); d.gk = (GK_); d.gn = nullptr; d.scale = (SC_); d.WT = (WT_); d.ldt = (K_); d.drow_off = 0; d.mode = (MODE_); return; } r -= cnt_; }
__device__ __forceinline__ void td_desc(const Args& a, unsigned char* ws, int l, int r, TD& d) {
    const size_t LW = (size_t)1024 * 4096;
    const float* g_f1 = a.in[4] + l * 1024; const float* g_f2 = a.in[31] + l * 1024; const float* g_cr = a.in[26] + l * 1024; const float* g_mem = a.in[27] + l * 1024;
    TDS(a.in[5] + l * LW, 1024, 4096, g_f1, 1.0f, (bf16*)(ws + WS_WGU1), 1)
    TDS(a.in[6] + l * LW, 1024, 4096, g_f1, 1.0f, (bf16*)(ws + WS_WGU1), 2)
    TDS(a.in[7] + l * LW, 4096, 1024, nullptr, 1.0f, (bf16*)(ws + WS_WD1), 0)
    TDS(a.in[32] + l * LW, 1024, 4096, g_f2, 1.0f, (bf16*)(ws + WS_WGU2), 1)
    TDS(a.in[33] + l * LW, 1024, 4096, g_f2, 1.0f, (bf16*)(ws + WS_WGU2), 2)
    TDS(a.in[34] + l * LW, 4096, 1024, nullptr, 1.0f, (bf16*)(ws + WS_WD2), 0)
    TDS(a.in[28] + (size_t)l * 1024 * 1024, 1024, 1024, g_cr, 0.0625f * 1.4426950408889634f, (bf16*)(ws + WS_WQ), 0)
    TDS(a.in[29] + (size_t)l * 1024 * 2048, 1024, 2048, g_mem, 1.0f, (bf16*)(ws + WS_WKV), 0)
    TDS(a.in[30] + (size_t)l * 1024 * 1024, 1024, 1024, nullptr, 1.0f, (bf16*)(ws + WS_WO), 0)
    if (l == 0) {
        TDS(a.in[9], 1024, 1536, a.in[8], 1.0f, (bf16*)(ws + WS_WIN), 0)
        TDS(a.in[18], 512, 512, nullptr, 1.0f, (bf16*)(ws + WS_WGLU), 0)
        TDS(a.in[23], 1024, 1024, nullptr, 1.0f, (bf16*)(ws + WS_WOUT), 0)
    }
    { const int gi = (r >> 2) & 3, kb = r & 3;
      d.W = a.in[24] + (size_t)gi * 65536; d.ldw = 256; d.k0 = 64 * kb; d.n0 = 0; d.gk = a.in[8] + 1024 + gi * 256; d.gn = a.in[25] + gi * 256; d.scale = 1.0f; d.WT = (bf16*)(ws + WS_WPOOL); d.ldt = 256; d.drow_off = gi * 256; d.mode = 0; }
}
__device__ __forceinline__ void prep_weights(const Args& a, unsigned char* ws, LAS unsigned char* lds, int l, int bx, int G, int tid, int sel) {
    tid = opq(tid);
    LAS float* scr = (LAS float*)lds;
    const int nall = 6 * 256 + 64 + 128 + 64 + (l == 0 ? 96 + 16 + 64 : 16);
    const int nitems = sel == 0 ? nall : sel == 1 ? 768 + (nall - 1536) : sel == 2 ? 512 : 256;
#define PW_MAP(i_) (sel == 0 ? (i_) : sel == 1 ? ((i_) < 768 ? (i_) : (i_) + 768) : sel == 2 ? (i_) + 768 : (i_) + 1280)
    int it = bx; if (it >= nitems) return;
    TD cur; td_desc(a, ws, l, PW_MAP(it), cur);
    f32x4 v[8]; td_load(cur, tid, v);
    for (;;) {
        const int itn = it + G; const bool more = itn < nitems;
        TD nxt = cur; f32x4 vn[8];
        if (more) { td_desc(a, ws, l, PW_MAP(itn), nxt); td_load(nxt, tid, vn); }
        td_store(cur, tid, v, scr);
        if (!more) break;
#pragma unroll
        for (int i = 0; i < 8; ++i) v[i] = vn[i];
        cur = nxt; it = itn;
    }
#undef PW_MAP
}

__device__ __forceinline__ void sincos_turns(double t, double& c, double& s) {
    t -= __builtin_rint(t);
    const double n = __builtin_rint(4.0 * t); const double r = t - 0.25 * n; const double x = 6.283185307179586476925 * r, x2 = x * x;
    double sp = -7.647163731819816e-13; sp = sp * x2 + 1.605904383682161e-10; sp = sp * x2 - 2.505210838544172e-08; sp = sp * x2 + 2.755731922398589e-06; sp = sp * x2 - 1.984126984126984e-04; sp = sp * x2 + 8.333333333333333e-03; sp = sp * x2 - 1.666666666666667e-01; sp = sp * x2 * x + x;
    double cp = 4.779477332387385e-14; cp = cp * x2 - 1.147074559772972e-11; cp = cp * x2 + 2.087675698786810e-09; cp = cp * x2 - 2.755731922398589e-07; cp = cp * x2 + 2.480158730158730e-05; cp = cp * x2 - 1.388888888888889e-03; cp = cp * x2 + 4.166666666666666e-02; cp = cp * x2 - 0.5; cp = cp * x2 + 1.0;
    const int q = ((int)n) & 3;
    c = (q == 0) ? cp : (q == 1) ? -sp : (q == 2) ? -cp : sp;
    s = (q == 0) ? sp : (q == 1) ? cp : (q == 2) ? -sp : -cp;
}
__device__ __forceinline__ void prep_misc(const Args& a, unsigned char* ws, int gw, int NGW, int gt, int NT, int lane) {
    gw = opq(gw); gt = opq(gt); lane = opq(lane);
    bf16* XB = (bf16*)(ws + WS_XB); float* SSQ0 = (float*)(ws + WS_SSQ0);
    for (int r0 = gw; r0 < M; r0 += 4 * NGW) {
        f32x4 v[4][4];
#pragma unroll
        for (int q = 0; q < 4; ++q) { const int r = r0 + q * NGW < M ? r0 + q * NGW : r0; const float* src = r < 32768 ? a.in[0] + (size_t)r * D : a.in[1] + (size_t)(r - 32768) * D;
#pragma unroll
            for (int j = 0; j < 4; ++j) v[q][j] = __builtin_nontemporal_load((const f32x4*)src + lane + 64 * j); }
#pragma unroll
        for (int q = 0; q < 4; ++q) { const int r = r0 + q * NGW < M ? r0 + q * NGW : r0; float s = 0.f;
#pragma unroll
            for (int j = 0; j < 4; ++j) { const f32x4 x = v[q][j]; s += (x[0] * x[0] + x[1] * x[1]) + (x[2] * x[2] + x[3] * x[3]);
                v2u w; w.x = cvt_pk_bf16(x[0], x[1]); w.y = cvt_pk_bf16(x[2], x[3]); ((v2u*)(XB + (size_t)r * D))[lane + 64 * j] = w; }
            s = wave_sum(s);
            if (lane < 16) SSQ0[(size_t)r * 16 + lane] = lane == 0 ? s : 0.f; }
    }
    bf16* MEMB = (bf16*)(ws + WS_MEMB); float* SSQM = (float*)(ws + WS_SSQM); float* RSM = (float*)(ws + WS_RSM);
    for (int r = gw; r < 4096; r += NGW) {
        const float* src = r < 2048 ? a.in[2] + (size_t)r * D : a.in[3] + (size_t)(r - 2048) * D;
        float s = 0.f;
#pragma unroll
        for (int j = 0; j < 4; ++j) { const f32x4 v = __builtin_nontemporal_load((const f32x4*)src + lane + 64 * j); s += (v[0] * v[0] + v[1] * v[1]) + (v[2] * v[2] + v[3] * v[3]);
            v2u w; w.x = cvt_pk_bf16(v[0], v[1]); w.y = cvt_pk_bf16(v[2], v[3]); ((v2u*)(MEMB + (size_t)r * D))[lane + 64 * j] = w; }
        s = wave_sum(s);
        if (lane < 16) SSQM[(size_t)r * 16 + lane] = lane == 0 ? s : 0.f;
        if (lane == 0) RSM[r] = rsq_eps(s);
    }
    { bf16* WSB = (bf16*)(ws + WS_WSB); for (int i = gt; i < 4 * 128 * 128; i += NT) WSB[i] = f2bf(a.in[21][i]); }
    f32x2* APOW = (f32x2*)(ws + WS_APOW); f32x2* BBAR = (f32x2*)(ws + WS_BBAR);
    for (int idx = gt; idx < 2 * 32 * 64; idx += NT) {
        const int p = idx & 63, dg = idx >> 6;
        const double lre = (double)a.in[10][idx], lim = (double)a.in[11][idx]; const double dt = exp((double)a.in[12][dg]);
        const double lr = lre * dt, tn = lim * dt * 0.15915494309189533577;
        double a1r = 0., a1i = 0.;
        for (int k = 0; k <= 32; ++k) { const double mag = exp((double)k * lr); double c, s; sincos_turns((double)k * tn, c, s); APOW[((size_t)dg * 33 + k) * 64 + p] = (f32x2){(float)(mag * c), (float)(mag * s)}; if (k == 1) { a1r = mag * c; a1i = mag * s; } }
        const double nr = a1r - 1.0, ni = a1i, den = lre * lre + lim * lim; const double qr = (nr * lre + ni * lim) / den, qi = (ni * lre - nr * lim) / den;
#pragma unroll 4
        for (int c = 0; c < 16; ++c) { const double br = (double)a.in[13][(size_t)idx * 16 + c], bi = (double)a.in[14][(size_t)idx * 16 + c]; BBAR[(size_t)idx * 16 + c] = (f32x2){(float)(qr * br - qi * bi), (float)(qr * bi + qi * br)}; }
    }
}
__device__ __forceinline__ void s5_tab2(const Args& a, unsigned char* ws, int gt, int NT) {
    gt = opq(gt);
    const f32x2* APOW = (const f32x2*)(ws + WS_APOW); const f32x2* BBAR = (const f32x2*)(ws + WS_BBAR); float* KTAB = (float*)(ws + WS_KTAB);
    for (int e = gt; e < 32 * 2 * 32 * 256; e += NT) {
        const int cc = e & 15, c = (e >> 4) & 15, k = (e >> 8) & 31, dir = (e >> 13) & 1, g = e >> 14, dg = dir * 32 + g;
        const f32x2* ap = APOW + ((size_t)dg * 33 + k) * 64; const float* cre = a.in[15] + ((size_t)dg * 16 + c) * 64; const float* cim = a.in[16] + ((size_t)dg * 16 + c) * 64; const f32x2* bb = BBAR + (size_t)dg * 1024 + cc;
        float acc = 0.f;
#pragma unroll 8
        for (int p = 0; p < 64; ++p) { const f32x2 av = ap[p]; const float cr = cre[p], ci = cim[p]; const float car = cr * av.x - ci * av.y, cai = cr * av.y + ci * av.x; const f32x2 b = bb[p * 16]; acc += car * b.x - cai * b.y; }
        KTAB[e] = acc;
    }
}
__device__ __forceinline__ void s5_tab3(const Args& a, unsigned char* ws, int gt, int NT) {
    gt = opq(gt);
    const f32x2* APOW = (const f32x2*)(ws + WS_APOW); const f32x2* BBAR = (const f32x2*)(ws + WS_BBAR); const float* KTAB = (const float*)(ws + WS_KTAB);
    bf16* BT = (bf16*)(ws + WS_BT); bf16* B1S = (bf16*)(ws + WS_B1S);
    for (int idx = gt; idx < 32 * 512 * 96; idx += NT) {
        const int kp = idx % 96, n = (idx / 96) & 511, g = idx / (96 * 512), t = n >> 4, c = n & 15;
        float v[8];
        if (kp < 64) {
            const int s = kp >> 1, c0 = (kp & 1) * 8;
            if (s != t) { const int dir = s < t ? 0 : 1, k = s < t ? t - s : s - t; const f32x4* kt = (const f32x4*)(KTAB + ((size_t)((g * 2 + dir) * 32 + k) * 256 + c * 16 + c0)); const f32x4 x0 = kt[0], x1 = kt[1];
                v[0] = x0[0]; v[1] = x0[1]; v[2] = x0[2]; v[3] = x0[3]; v[4] = x1[0]; v[5] = x1[1]; v[6] = x1[2]; v[7] = x1[3]; }
            else { const f32x4* k0 = (const f32x4*)(KTAB + ((size_t)((g * 2 + 0) * 32) * 256 + c * 16 + c0)); const f32x4* k1 = (const f32x4*)(KTAB + ((size_t)((g * 2 + 1) * 32) * 256 + c * 16 + c0));
                const f32x4 x0 = k0[0] + k1[0], x1 = k0[1] + k1[1]; const float dv = a.in[17][g * 16 + c];
                v[0] = x0[0]; v[1] = x0[1]; v[2] = x0[2]; v[3] = x0[3]; v[4] = x1[0]; v[5] = x1[1]; v[6] = x1[2]; v[7] = x1[3];
#pragma unroll
                for (int i = 0; i < 8; ++i) v[i] += (c == c0 + i) ? dv : 0.f; }
        } else {
            const int j = kp - 64, dir = j >> 4, i8 = (j & 15) * 8, im = i8 >> 6, p0 = i8 & 63, e = dir == 0 ? t + 1 : 32 - t, dg = dir * 32 + g;
            const f32x2* ap = APOW + ((size_t)dg * 33 + e) * 64 + p0; const float* cre = a.in[15] + ((size_t)dg * 16 + c) * 64 + p0; const float* cim = a.in[16] + ((size_t)dg * 16 + c) * 64 + p0;
#pragma unroll
            for (int i = 0; i < 8; ++i) { const f32x2 av = ap[i]; const float cr = cre[i], ci = cim[i]; v[i] = im ? -(cr * av.y + ci * av.x) : (cr * av.x - ci * av.y); }
        }
        v4u o; o.x = cvt_pk_bf16(v[0], v[1]); o.y = cvt_pk_bf16(v[2], v[3]); o.z = cvt_pk_bf16(v[4], v[5]); o.w = cvt_pk_bf16(v[6], v[7]);
        *(v4u*)(BT + ((size_t)(g * 512 + n) * 768 + kp * 8)) = o;
    }
    for (int idx = gt; idx < 32 * 256 * 64; idx += NT) {
        const int kp = idx & 63, n = (idx >> 6) & 255, g = idx >> 14, s = kp >> 1, c0 = (kp & 1) * 8, dir = n >> 7, im = (n >> 6) & 1, p = n & 63, e = dir == 0 ? 31 - s : s, dg = dir * 32 + g;
        const f32x2 av = APOW[((size_t)dg * 33 + e) * 64 + p]; const f32x2* bb = BBAR + ((size_t)dg * 64 + p) * 16 + c0;
        float v[8];
#pragma unroll
        for (int i = 0; i < 8; ++i) { const f32x2 b = bb[i]; v[i] = im ? (av.x * b.y + av.y * b.x) : (av.x * b.x - av.y * b.y); }
        v4u o; o.x = cvt_pk_bf16(v[0], v[1]); o.y = cvt_pk_bf16(v[2], v[3]); o.z = cvt_pk_bf16(v[4], v[5]); o.w = cvt_pk_bf16(v[6], v[7]);
        *(v4u*)(B1S + ((size_t)(g * 256 + n) * 512 + kp * 8)) = o;
    }
}
__device__ __forceinline__ void s5_scan(unsigned char* ws, int gt) {
    gt = opq(gt);
    if (gt >= 16 * 32 * 2 * 64) return;
    const int p = gt & 63, dir = (gt >> 6) & 1, g = (gt >> 7) & 31, seq = gt >> 12;
    const int ch0 = seq < 8 ? seq * 128 : 1024 + (seq - 8) * 64, nch = seq < 8 ? 128 : 64;
    const f32x2 a32 = ((const f32x2*)(ws + WS_APOW))[((size_t)(dir * 32 + g) * 33 + 32) * 64 + p];
    const float* S = (const float*)(ws + WS_SST) + (size_t)g * 1536 * 256 + dir * 128 + p; bf16* AP = (bf16*)(ws + WS_AP) + (size_t)g * 1536 * 768 + 512 + dir * 128 + p;
    float hr = 0.f, hi = 0.f;
#pragma unroll 8
    for (int i = 0; i < nch; ++i) {
        const int ch = ch0 + (dir == 0 ? i : nch - 1 - i);
        const float sr = S[(size_t)ch * 256], si = S[(size_t)ch * 256 + 64];
        AP[(size_t)ch * 768] = f2bf(hr); AP[(size_t)ch * 768 + 64] = f2bf(hi);
        const float nr = a32.x * hr - a32.y * hi + sr, ni = a32.x * hi + a32.y * hr + si; hr = nr; hi = ni;
    }
}
__device__ __forceinline__ void sgu_phase(LAS unsigned char* lds, const Args& a, unsigned char* ws, int ubeg, int uend, int rel, int nrel, int tid) {
    if (rel < 0) return;
    const int tid0 = tid;
    const bf16* ZUB = (const bf16*)(ws + WS_ZUB); const bf16* ZVB = (const bf16*)(ws + WS_ZVB); const float* LNP = (const float*)(ws + WS_LNP); const bf16* WSB = (const bf16*)(ws + WS_WSB); bf16* CAT = (bf16*)a.out;
    const float* ng = a.in[19]; const float* nb = a.in[20]; const float* bs = a.in[22];
    LAS bf16* VTl = (LAS bf16*)lds;
    for (int unit = ubeg + rel; unit < uend; unit += nrel) {
        const int tid = opq(tid0), lane = tid & 63, wave = tid >> 6, fr = lane & 15, fq = lane >> 4;
        const int ck = unit >> 2, h = unit & 3, tok0 = ck * 128, j = tid >> 2;
        float s1 = 0.f, s2 = 0.f;
        { const f32x4* lp = (const f32x4*)(LNP + (size_t)(tok0 + j) * 16);
#pragma unroll
          for (int q = 0; q < 4; ++q) { const f32x4 v = lp[q]; s1 += v[0] + v[2]; s2 += v[1] + v[3]; } }
        const float mean = s1 * (1.0f / 512.0f), var = s2 * (1.0f / 512.0f) - mean * mean, rstd = __builtin_amdgcn_rsqf(var + 1e-6f);
#pragma unroll
        for (int it = 0; it < 4; ++it) {
            const int d0 = ((tid & 3) + 4 * it) * 8;
            const v4u raw = *(const v4u*)(ZVB + (size_t)(tok0 + j) * 512 + h * 128 + d0);
            const f32x4 g0 = *(const f32x4*)(ng + h * 128 + d0), g1 = *(const f32x4*)(ng + h * 128 + d0 + 4), b0 = *(const f32x4*)(nb + h * 128 + d0), b1 = *(const f32x4*)(nb + h * 128 + d0 + 4);
            float x[8] = {bf_lo(raw.x), bf_hi(raw.x), bf_lo(raw.y), bf_hi(raw.y), bf_lo(raw.z), bf_hi(raw.z), bf_lo(raw.w), bf_hi(raw.w)};
#pragma unroll
            for (int e = 0; e < 8; ++e) { const float gg = e < 4 ? g0[e & 3] : g1[e & 3], bb = e < 4 ? b0[e & 3] : b1[e & 3]; VTl[(d0 + e) * 136 + j] = f2bf((x[e] - mean) * rstd * gg + bb); }
        }
        __syncthreads();
        bf16x8 wsf[4];
#pragma unroll
        for (int kk = 0; kk < 4; ++kk) wsf[kk] = *(const bf16x8*)(WSB + (size_t)(h * 128 + wave * 16 + fr) * 128 + 32 * kk + 8 * fq);
        f32x4 acc[8];
#pragma unroll
        for (int dt = 0; dt < 8; ++dt) acc[dt] = (f32x4){0.f, 0.f, 0.f, 0.f};
#pragma unroll
        for (int kk = 0; kk < 4; ++kk)
#pragma unroll
            for (int dt = 0; dt < 8; ++dt) { const bf16x8 vf = *(const LAS bf16x8*)(VTl + (16 * dt + fr) * 136 + 32 * kk + 8 * fq); acc[dt] = __builtin_amdgcn_mfma_f32_16x16x32_bf16(vf, wsf[kk], acc[dt], 0, 0, 0); }
        const int token = tok0 + wave * 16 + fr; const float bias = bs[h * 128 + wave * 16 + fr];
#pragma unroll
        for (int dt = 0; dt < 8; ++dt) { const int d = 16 * dt + 4 * fq; const v2u ub = *(const v2u*)(ZUB + (size_t)token * 512 + h * 128 + d);
            v2u o; o.x = cvt_pk_bf16(bf_lo(ub.x) * (acc[dt][0] + bias), bf_hi(ub.x) * (acc[dt][1] + bias)); o.y = cvt_pk_bf16(bf_lo(ub.y) * (acc[dt][2] + bias), bf_hi(ub.y) * (acc[dt][3] + bias));
            *(v2u*)(CAT + (size_t)token * 1024 + 512 + h * 128 + d) = o; }
        __syncthreads();
    }
}
__device__ __forceinline__ void pool_phase(LAS unsigned char* lds, const bf16* XB, const float* part, bf16* P, int G, int bx, int tid0) {
    LAS float* tile = (LAS float*)lds;
    LAS float* rsl = (LAS float*)(lds + 98304);
    for (int unit = bx; unit < 3072; unit += G) {
        const int tid = opq(tid0);
        const int t0 = (unit >> 1) * 32, hf = unit & 1; const int seq0 = t0 < 32768 ? (t0 & ~4095) : (t0 & ~2047), L = t0 < 32768 ? 4096 : 2048;
        __syncthreads();
        if (tid < 48) { int r = t0 - 8 + tid; r = r < 0 ? 0 : (r > M - 1 ? M - 1 : r); const f32x4* pp = (const f32x4*)(part + (size_t)r * 16); const f32x4 s4 = (pp[0] + pp[1]) + (pp[2] + pp[3]); rsl[tid] = rsq_eps((s4[0] + s4[1]) + (s4[2] + s4[3])); }
        v2u v[12];
#pragma unroll
        for (int i = 0; i < 12; ++i) { const int idx = tid + 512 * i, row = idx >> 7, q = idx & 127; int r = t0 - 8 + row; r = r < 0 ? 0 : (r > M - 1 ? M - 1 : r); v[i] = __builtin_nontemporal_load((const v2u*)(XB + (size_t)r * 1024 + hf * 512 + q * 4)); }
        __syncthreads();
#pragma unroll
        for (int i = 0; i < 12; ++i) { const int idx = tid + 512 * i, row = idx >> 7, q = idx & 127; *(LAS f32x4*)(tile + row * 512 + q * 4) = (f32x4){bf_lo(v[i].x), bf_hi(v[i].x), bf_lo(v[i].y), bf_hi(v[i].y)} * rsl[row]; }
        __syncthreads();
        const int q = tid & 127, rg = tid >> 7, ch0 = hf * 512 + q * 4, gi = ch0 >> 8, hw = 1 << gi;
        int pos = t0 + rg * 8 - seq0; const int lr0 = 8 - (t0 - seq0);
#define TL(p_) (*(const LAS f32x4*)(tile + ((p_) + lr0) * 512 + q * 4))
        f32x4 s = (f32x4){0.f, 0.f, 0.f, 0.f};
        { const int lo = pos - hw < 0 ? 0 : pos - hw, hi = pos + hw > L ? L : pos + hw; for (int j2 = lo; j2 < hi; ++j2) s += TL(j2); }
#pragma unroll
        for (int i = 0; i < 8; ++i, ++pos) {
            const int lo = pos - hw < 0 ? 0 : pos - hw, hi = pos + hw > L ? L : pos + hw;
            const f32x4 o = s * (1.0f / (float)(hi - lo)) - TL(pos);
            v2u w; w.x = cvt_pk_bf16(o[0], o[1]); w.y = cvt_pk_bf16(o[2], o[3]); *(v2u*)(P + (size_t)(seq0 + pos) * 1024 + ch0) = w;
            if (i < 7) { if (pos + hw < L) s += TL(pos + hw); if (pos - hw >= 0) s -= TL(pos - hw); }
        }
#undef TL
    }
}
__device__ __forceinline__ void attn_phase(LAS unsigned char* lds, const bf16* QO, bf16* OB, const bf16* KB, const bf16* VT, int G, int bx, int tid) {
    constexpr int BUF = 69632;
    const int tid0 = tid;
    const int vcu = (G % 8 == 0) ? (bx % 8) * (G / 8) + bx / 8 : bx;
    for (int unit = vcu; unit < 768; unit += G) {
        const int tid = opq(tid0), lane = tid & 63, wave = tid >> 6, fr = lane & 15, fq = lane >> 4;
        int b16, h, row0;
        if (unit < 512) { b16 = unit >> 6; h = (unit >> 4) & 3; row0 = b16 * 4096 + (unit & 15) * 256; }
        else { const int u2 = unit - 512; b16 = 8 + (u2 >> 5); h = (u2 >> 3) & 3; row0 = 32768 + (b16 - 8) * 2048 + (u2 & 7) * 256; }
        const size_t qoff = (size_t)(row0 + wave * 32 + fr) * 1024 + h * 256;
        bf16x8 qf[2][8];
#pragma unroll
        for (int t = 0; t < 2; ++t)
#pragma unroll
            for (int kk = 0; kk < 8; ++kk) qf[t][kk] = *(const bf16x8*)(QO + qoff + (size_t)t * 16 * 1024 + 32 * kk + 8 * fq);
        const bf16* kbase = KB + (size_t)(b16 * 256) * 1024 + h * 256;
#pragma unroll
        for (int hh = 0; hh < 2; ++hh) {
            v4u tmp[8];
#pragma unroll
            for (int it = 0; it < 8; ++it) tmp[it] = *(const v4u*)(kbase + (size_t)(hh * 128 + (tid >> 5) + 16 * it) * 1024 + (tid & 31) * 8);
#pragma unroll
            for (int it = 0; it < 8; ++it) *(LAS v4u*)(lds + hh * BUF + ((tid >> 5) + 16 * it) * 528 + (tid & 31) * 16) = tmp[it];
        }
        __syncthreads();
        f32x4 sacc[2][16];
#pragma unroll
        for (int n = 0; n < 16; ++n) { sacc[0][n] = (f32x4){0.f, 0.f, 0.f, 0.f}; sacc[1][n] = (f32x4){0.f, 0.f, 0.f, 0.f}; }
        {
#define KRD(i_) (*(const LAS bf16x8*)(lds + ((i_) >> 6) * BUF + ((((i_) >> 3) & 7) * 16 + fr) * 528 + (32 * ((i_) & 7) + 8 * fq) * 2))
            bf16x8 kfb[4];
#pragma unroll
            for (int i = 0; i < 4; ++i) kfb[i] = KRD(i);
#pragma unroll
            for (int i = 0; i < 128; ++i) { const bf16x8 c = kfb[i & 3]; if (i + 4 < 128) kfb[i & 3] = KRD(i + 4);
                sacc[0][i >> 3] = __builtin_amdgcn_mfma_f32_16x16x32_bf16(c, qf[0][i & 7], sacc[0][i >> 3], 0, 0, 0); sacc[1][i >> 3] = __builtin_amdgcn_mfma_f32_16x16x32_bf16(c, qf[1][i & 7], sacc[1][i >> 3], 0, 0, 0); }
#undef KRD
        }
        __syncthreads();
        const bf16* vbase = VT + (size_t)(h * 256) * 4096 + b16 * 256;
#pragma unroll
        for (int hh = 0; hh < 2; ++hh) {
            v4u tmp[8];
#pragma unroll
            for (int it = 0; it < 8; ++it) tmp[it] = *(const v4u*)(vbase + (size_t)((tid >> 4) + 32 * it) * 4096 + hh * 128 + (tid & 15) * 8);
#pragma unroll
            for (int it = 0; it < 8; ++it) *(LAS v4u*)(lds + hh * BUF + ((tid >> 4) + 32 * it) * 272 + (tid & 15) * 16) = tmp[it];
        }
        bf16x8 pf[2][8]; float inv[2];
#pragma unroll
        for (int t = 0; t < 2; ++t) {
            float mx = -3.0e38f;
#pragma unroll
            for (int n = 0; n < 16; ++n) mx = fmaxf(fmaxf(mx, fmaxf(sacc[t][n][0], sacc[t][n][1])), fmaxf(sacc[t][n][2], sacc[t][n][3]));
            mx = fmaxf(mx, __shfl_xor(mx, 16)); mx = fmaxf(mx, __shfl_xor(mx, 32));
            float lsum = 0.f;
#pragma unroll
            for (int n = 0; n < 16; ++n) {
#pragma unroll
                for (int e = 0; e < 4; ++e) { const float pv = __builtin_amdgcn_exp2f(sacc[t][n][e] - mx); sacc[t][n][e] = pv; lsum += pv; } }
            lsum += __shfl_xor(lsum, 16); lsum += __shfl_xor(lsum, 32);
            inv[t] = __builtin_amdgcn_rcpf(lsum);
#pragma unroll
            for (int kk = 0; kk < 8; ++kk) { v4u w; w.x = cvt_pk_bf16(sacc[t][2 * kk][0], sacc[t][2 * kk][1]); w.y = cvt_pk_bf16(sacc[t][2 * kk][2], sacc[t][2 * kk][3]); w.z = cvt_pk_bf16(sacc[t][2 * kk + 1][0], sacc[t][2 * kk + 1][1]); w.w = cvt_pk_bf16(sacc[t][2 * kk + 1][2], sacc[t][2 * kk + 1][3]); pf[t][kk] = __builtin_bit_cast(bf16x8, w); }
        }
        __syncthreads();
        {
#define VRD(i_, off_) (*(const LAS v2u*)(lds + (((i_) & 7) >> 2) * BUF + (16 * ((i_) >> 3) + fr) * 272 + ((((i_) & 7) & 3) * 32 + 4 * fq) * 2 + (off_)))
            v2u vlo[4], vhi[4];
#pragma unroll
            for (int i = 0; i < 4; ++i) { vlo[i] = VRD(i, 0); vhi[i] = VRD(i, 32); }
            f32x4 o0 = (f32x4){0.f, 0.f, 0.f, 0.f}, o1 = (f32x4){0.f, 0.f, 0.f, 0.f};
#pragma unroll
            for (int i = 0; i < 128; ++i) {
                v4u w; w.x = vlo[i & 3].x; w.y = vlo[i & 3].y; w.z = vhi[i & 3].x; w.w = vhi[i & 3].y; const bf16x8 vf = __builtin_bit_cast(bf16x8, w);
                if (i + 4 < 128) { vlo[i & 3] = VRD(i + 4, 0); vhi[i & 3] = VRD(i + 4, 32); }
                o0 = __builtin_amdgcn_mfma_f32_16x16x32_bf16(vf, pf[0][i & 7], o0, 0, 0, 0); o1 = __builtin_amdgcn_mfma_f32_16x16x32_bf16(vf, pf[1][i & 7], o1, 0, 0, 0);
                if ((i & 7) == 7) { const int dt = i >> 3;
                    v2u ow; ow.x = cvt_pk_bf16(o0[0] * inv[0], o0[1] * inv[0]); ow.y = cvt_pk_bf16(o0[2] * inv[0], o0[3] * inv[0]);
                    *(v2u*)(OB + qoff + 16 * dt + 4 * fq) = ow;
                    ow.x = cvt_pk_bf16(o1[0] * inv[1], o1[1] * inv[1]); ow.y = cvt_pk_bf16(o1[2] * inv[1], o1[3] * inv[1]);
                    *(v2u*)(OB + qoff + (size_t)16 * 1024 + 16 * dt + 4 * fq) = ow;
                    o0 = (f32x4){0.f, 0.f, 0.f, 0.f}; o1 = (f32x4){0.f, 0.f, 0.f, 0.f}; }
            }
#undef VRD
        }
        __syncthreads();
    }
}

#define XB_TMO      128
#define XB_XCNT(j)  (256  + 64 * (j))
#define XB_XSUB(j)  (1280 + 64 * (j))
#define XB_XGEN(j)  (2304 + 64 * (j))
#define XB_TOP      3328
#define XB_TOPGEN   3392
#define XCD_BAR_WORDS 3456
#define XB_SPIN_CAP (1u << 18)

__device__ __forceinline__ unsigned xb_ld(unsigned* p)              { return __hip_atomic_load(p, __ATOMIC_RELAXED, __HIP_MEMORY_SCOPE_AGENT); }
__device__ __forceinline__ unsigned xb_add(unsigned* p, unsigned v) { return __hip_atomic_fetch_add(p, v, __ATOMIC_RELAXED, __HIP_MEMORY_SCOPE_AGENT); }
__device__ __forceinline__ unsigned xb_xcc_id() { return (unsigned)__builtin_amdgcn_s_getreg((3 << 11) | 20) & 0xFu; }
#define XB_SPIN(cond, bar) do { unsigned _sp = 0; while (cond) { __builtin_amdgcn_s_sleep(1); \
    if ((++_sp & 255u) == 0u) { if (xb_ld(&(bar)[XB_TMO])) break; if (_sp > XB_SPIN_CAP) { atomicAdd(&(bar)[XB_TMO], 1u); break; } } } } while (0)

struct XcdBarrier {
    unsigned* bar; unsigned x;
    volatile LAS unsigned* st;
};

__device__ __forceinline__ XcdBarrier xcd_barrier_post(unsigned* bar, volatile LAS unsigned* st) {
    XcdBarrier b; b.bar = bar; b.x = xb_xcc_id(); b.st = st;
    if (threadIdx.x == 0) (void)xb_add(&bar[XB_XCNT(b.x)], 1u);
    return b;
}
__device__ __forceinline__ void xcd_barrier_complete(unsigned* bar, unsigned x, unsigned& nloc, unsigned& nx) {
    const unsigned G = gridDim.x * gridDim.y * gridDim.z;
    unsigned sum, cnt, mine, sp = 0u;
    for (;;) {
        sum = 0u; cnt = 0u; mine = 0u;
#pragma unroll
        for (unsigned j = 0; j < 16; ++j) { const unsigned c = xb_ld(&bar[XB_XCNT(j)]); sum += c; cnt += (c > 0u) ? 1u : 0u; mine = (j == x) ? c : mine; }
        if (sum == G) break;
        __builtin_amdgcn_s_sleep(1);
        if ((++sp & 255u) == 0u) { if (xb_ld(&bar[XB_TMO])) break; if (sp > XB_SPIN_CAP) { atomicAdd(&bar[XB_TMO], 1u); break; } }
    }
    nloc = mine > 0u ? mine : 1u; nx = cnt > 0u ? cnt : 1u;
}

__device__ __forceinline__ void xcd_barrier(const XcdBarrier& b) {
    asm volatile("s_waitcnt vmcnt(0)" ::: "memory");
    __syncthreads();
    if (threadIdx.x == 0) {
        unsigned* bar = b.bar;
        __builtin_amdgcn_s_waitcnt(0);
        unsigned nloc = b.st[0], nx = b.st[1];
        if (nloc == 0u) { xcd_barrier_complete(bar, b.x, nloc, nx); b.st[0] = nloc; b.st[1] = nx; }
        const unsigned old = xb_add(&bar[XB_XSUB(b.x)], 1u);
        const unsigned gen = old / nloc;
        if (old + 1u == (gen + 1u) * nloc) {
            __builtin_amdgcn_fence(__ATOMIC_RELEASE, "agent");
            asm volatile("s_waitcnt vmcnt(0)" ::: "memory");
            const unsigned og = xb_add(&bar[XB_TOP], 1u);
            const unsigned tg = og / nx;
            if (og + 1u == (tg + 1u) * nx) xb_add(&bar[XB_TOPGEN], 1u);
            else XB_SPIN(xb_ld(&bar[XB_TOPGEN]) == tg, bar);
            __builtin_amdgcn_fence(__ATOMIC_ACQUIRE, "agent");
            xb_add(&bar[XB_XGEN(b.x)], 1u);
            asm volatile("s_waitcnt vmcnt(0)" ::: "memory");
        } else {
            XB_SPIN(xb_ld(&bar[XB_XGEN(b.x)]) == gen, bar);
            __builtin_amdgcn_fence(__ATOMIC_ACQUIRE, "agent");
            asm volatile("s_waitcnt vmcnt(0)" ::: "memory");
        }
    }
    __syncthreads();
}

__device__ __forceinline__ void final_phase(float* OUT, const bf16* XB, const float* part, const float* gain, int gw, int NGW, int lane) {
    gw = opq(gw); lane = opq(lane);
    f32x4 g[4];
#pragma unroll
    for (int j = 0; j < 4; ++j) g[j] = ((const f32x4*)gain)[lane + 64 * j];
    for (int r0 = gw; r0 < M; r0 += 4 * NGW) {
        v2u w[4][4]; float s[4];
#pragma unroll
        for (int q = 0; q < 4; ++q) { const int r = r0 + q * NGW < M ? r0 + q * NGW : r0; s[q] = lane < 16 ? part[(size_t)r * 16 + lane] : 0.f;
#pragma unroll
            for (int j = 0; j < 4; ++j) w[q][j] = __builtin_nontemporal_load((const v2u*)(XB + (size_t)r * D) + lane + 64 * j); }
#pragma unroll
        for (int q = 0; q < 4; ++q) { const int r = r0 + q * NGW < M ? r0 + q * NGW : r0; const float rs = rsq_eps(wave_sum(s[q]));
#pragma unroll
            for (int j = 0; j < 4; ++j) { const f32x4 v = (f32x4){bf_lo(w[q][j].x), bf_hi(w[q][j].x), bf_lo(w[q][j].y), bf_hi(w[q][j].y)} * g[j] * rs; __builtin_nontemporal_store(v, (f32x4*)(OUT + (size_t)r * D) + lane + 64 * j); } }
    }
}

#define XBAR() do { xcd_barrier(bar); if (REP_BAR) xcd_barrier(bar); } while (0)
#ifndef REP_A
#define REP_A 0
#endif
#ifndef REP_Q
#define REP_Q 0
#endif
#ifndef REP_KV
#define REP_KV 0
#endif
#ifndef REP_SCAN
#define REP_SCAN 0
#endif
#ifndef REP_SGU
#define REP_SGU 0
#endif
#ifndef REP_WIN
#define REP_WIN 0
#endif
#ifndef REP_TAB
#define REP_TAB 0
#endif
#ifndef REP_BAR
#define REP_BAR 0
#endif
#ifndef REP_PREP
#define REP_PREP 0
#endif
#ifndef REP_S5
#define REP_S5 0
#endif
#ifndef REP_ATT
#define REP_ATT 0
#endif
#ifndef REP_RES
#define REP_RES 0
#endif
#define REPEAT(flag_, ...) do { __VA_ARGS__ if (flag_) { __VA_ARGS__ } } while (0)
#ifndef REP_GU
#define REP_GU 0
#endif
#ifndef REP_DOWN
#define REP_DOWN 0
#endif
#define GEMM(EPI, g_, nM_, nN_, nG_, c_, E_) do { pg8::Order S_; S_.init(nM_, nN_, nG_, G, c_); pg8::gemm_phase<EPI, pg8::Order, true, true>(lds, g_, S_, E_); } while (0)
#define GEMM_NA(EPI, g_, nM_, nN_, nG_, c_, E_) do { pg8::Order S_; S_.init(nM_, nN_, nG_, G, c_); pg8::gemm_phase<EPI, pg8::Order, false, true>(lds, g_, S_, E_); } while (0)

__global__ void __launch_bounds__(512, 2) mk_fwd(Args a) {
    extern __shared__ __attribute__((aligned(16))) unsigned char lds_raw[];
    LAS unsigned char* lds = (LAS unsigned char*)lds_raw;
    cg::grid_group grid = cg::this_grid();
    const int tid = threadIdx.x, lane = tid & 63, wave = __builtin_amdgcn_readfirstlane(tid >> 6);
    const int G = gridDim.x, bx = blockIdx.x;
    const int gw = bx * 8 + wave, NGW = G * 8, gt = bx * 512 + tid, NT = G * 512;
    unsigned char* ws = a.ws;
    float* X = a.out;
    bf16* XB = (bf16*)(ws + WS_XB); bf16* H = (bf16*)(ws + WS_H); bf16* QO = (bf16*)(ws + WS_QO); bf16* MEMB = (bf16*)(ws + WS_MEMB); bf16* KB = (bf16*)(ws + WS_KB); bf16* VT = (bf16*)(ws + WS_VT);
    bf16* WKV = (bf16*)(ws + WS_WKV);
#define SSQ(i) ((float*)(ws + ((i) ? WS_SSQ1 : WS_SSQ0)))
    constexpr size_t T1K = (size_t)256 * 1024 * 2;

    volatile LAS unsigned* bst = (volatile LAS unsigned*)(lds + 147392);
    if (tid < 2) bst[tid] = 0u;
    if (bx == 0) for (int i = tid; i < XCD_BAR_WORDS; i += 512) ((unsigned*)ws)[i] = 0u;
    __syncthreads();
    REPEAT(REP_PREP, prep_weights(a, ws, lds, 0, bx, G, tid, 0); prep_misc(a, ws, gw, NGW, gt, NT, lane); __syncthreads(););
    grid.sync();
    XcdBarrier bar = xcd_barrier_post((unsigned*)ws, bst);

    int cur = 0;
#pragma unroll 1
    for (int l = 0; l < 2; ++l) {
#pragma unroll 1
        for (int f = 0; f < 2; ++f) {
            const bf16* WGU = (const bf16*)(ws + (f ? WS_WGU2 : WS_WGU1)); const bf16* WD = (const bf16*)(ws + (f ? WS_WD2 : WS_WD1));
            { pg8::Gemm g{XB, WGU, 1024, 1024, 1024, T1K, 0, 0, T1K, 0, nullptr, 1 << 30}; pg8::EpiSwiGLU E{H, (bf16*)X, SSQ(cur)};
              GEMM(pg8::EpiSwiGLU, g, 192, 32, 1, bx, E);
#if REP_GU
              GEMM(pg8::EpiSwiGLU, g, 192, 32, 1, bx, E);
#endif
            }
            if (f == 0 && l == 1) REPEAT(REP_KV,
                { pg8::Gemm g{MEMB, WKV, 1024, 1024, 1024, T1K, 0, 0, T1K, 0, nullptr, 1 << 30}; pg8::EpiRowScale E{KB, 1024, (const float*)(ws + WS_SSQM)}; GEMM(pg8::EpiRowScale, g, 16, 4, 1, (bx + 64) % G, E); }
                { pg8::Gemm g{WKV + (size_t)1024 * 1024, MEMB, 1024, 1024, 1024, T1K, 0, 0, T1K, 0, nullptr, 1 << 30}; pg8::EpiVT E{VT, (const float*)(ws + WS_RSM)}; GEMM(pg8::EpiVT, g, 4, 16, 1, (bx + 128) % G, E); });
            if (f == 0 && l == 0) REPEAT(REP_TAB, s5_tab2(a, ws, gt, NT););
            if (l == 0 && f == 1) prep_weights(a, ws, lds, 1, bx, G, tid, 1);
            if (l == 1 && f == 0 && bx < G / 2) prep_weights(a, ws, lds, 1, bx, G / 2, tid, 3);
            XBAR();
            { pg8::Gemm g{H, WD, 4096, 4096, 4096, T1K * 4, 0, 0, T1K * 4, 0, (const bf16*)X, 128}; pg8::EpiRes E{XB, SSQ(cur ^ 1), 0.5f};
              GEMM(pg8::EpiRes, g, 192, 4, 1, bx, E);
#if REP_DOWN
              { pg8::EpiRes E2 = E; E2.alpha = 0.f; GEMM(pg8::EpiRes, g, 192, 4, 1, bx, E2); }
#endif
            }
            if (f == 0 && l == 0) REPEAT(REP_TAB, s5_tab3(a, ws, gt, NT););
            if (l == 0 && f == 1) prep_weights(a, ws, lds, 1, bx, G, tid, 2);
            XBAR();
            cur ^= 1;
            if (f == 0) {
                pg8::Gemm gm;
                if (l == 0) {
                    REPEAT(REP_WIN, { pg8::Gemm g{XB, (const bf16*)(ws + WS_WIN), 1024, 1024, 1024, T1K, 0, 0, T1K, 0, nullptr, 1 << 30}; pg8::EpiWin E{(bf16*)(ws + WS_AP), (bf16*)(ws + WS_ZUB), (bf16*)(ws + WS_ZVB), (pg8::f32x2*)(ws + WS_LNP), SSQ(cur)}; GEMM(pg8::EpiWin, g, 192, 6, 1, bx, E); });
                    REPEAT(REP_KV,
                        { pg8::Gemm g{MEMB, WKV, 1024, 1024, 1024, T1K, 0, 0, T1K, 0, nullptr, 1 << 30}; pg8::EpiRowScale E{KB, 1024, (const float*)(ws + WS_SSQM)}; GEMM(pg8::EpiRowScale, g, 16, 4, 1, (bx + 64) % G, E); }
                        { pg8::Gemm g{WKV + (size_t)1024 * 1024, MEMB, 1024, 1024, 1024, T1K, 0, 0, T1K, 0, nullptr, 1 << 30}; pg8::EpiVT E{VT, (const float*)(ws + WS_RSM)}; GEMM(pg8::EpiVT, g, 4, 16, 1, (bx + 128) % G, E); });
                    XBAR();
                    REPEAT(REP_S5, { pg8::Gemm g{(const bf16*)(ws + WS_AP), (const bf16*)(ws + WS_B1S), 768, 512, 512, (size_t)256 * 768 * 2, 0, (size_t)1536 * 768 * 2, 0, (size_t)256 * 512 * 2, nullptr, 1 << 30}; pg8::EpiS5aScan E{(float*)(ws + WS_SST), (bf16*)(ws + WS_AP), (const pg8::f32x2*)(ws + WS_APOW)}; GEMM_NA(pg8::EpiS5aScan, g, 6, 1, 32, bx, E); });
                    sgu_phase(lds, a, ws, 0, 640, (bx + 64) % G, G, tid);
                    XBAR();
                    REPEAT(REP_S5, { pg8::Gemm g{(const bf16*)(ws + WS_AP), (const bf16*)(ws + WS_BT), 768, 768, 768, (size_t)256 * 768 * 2, 0, (size_t)1536 * 768 * 2, (size_t)256 * 768 * 2, (size_t)512 * 768 * 2, nullptr, 1 << 30}; pg8::EpiS5c E{(bf16*)(ws + WS_GB)}; GEMM(pg8::EpiS5c, g, 6, 2, 32, bx, E); });
                    sgu_phase(lds, a, ws, 640, 1152, bx >= G / 2 ? bx - G / 2 : -1, G / 2, tid);
                    XBAR();
                    REPEAT(REP_S5, { pg8::Gemm g{(const bf16*)(ws + WS_GB), (const bf16*)(ws + WS_WGLU), 512, 512, 512, (size_t)256 * 512 * 2, 0, 0, (size_t)256 * 512 * 2, 0, nullptr, 1 << 30}; pg8::EpiGLU E{(const bf16*)(ws + WS_GB), (bf16*)X}; GEMM(pg8::EpiGLU, g, 192, 2, 1, bx, E); });
                    sgu_phase(lds, a, ws, 1152, 1536, bx >= G / 2 ? bx - G / 2 : -1, G / 2, tid);
                    XBAR();
                    gm = pg8::Gemm{(const bf16*)X, (const bf16*)(ws + WS_WOUT), 1024, 1024, 1024, T1K, 0, 0, T1K, 0, nullptr, 1 << 30};
                } else {
                    REPEAT(REP_RES, pool_phase(lds, XB, SSQ(cur), (bf16*)(ws + WS_POOLED), G, bx, tid););
                    XBAR();
                    gm = pg8::Gemm{(const bf16*)(ws + WS_POOLED), (const bf16*)(ws + WS_WPOOL), 1024, 256, 256, T1K, (size_t)256 * 2, 0, (size_t)256 * 256 * 2, 0, nullptr, 1 << 30};
                }
                { pg8::EpiRes E{XB, SSQ(cur ^ 1), 1.0f}; GEMM(pg8::EpiRes, gm, 192, 4, 1, bx, E); if (REP_RES) { E.alpha = 0.f; GEMM(pg8::EpiRes, gm, 192, 4, 1, bx, E); } }
                XBAR();
                cur ^= 1;
                { pg8::Gemm g{XB, (const bf16*)(ws + WS_WQ), 1024, 1024, 1024, T1K, 0, 0, T1K, 0, nullptr, 1 << 30}; pg8::EpiRowScale E{QO, 1024, SSQ(cur)}; REPEAT(REP_Q, GEMM(pg8::EpiRowScale, g, 192, 4, 1, bx, E);); }
                XBAR();
                REPEAT(REP_A, attn_phase(lds, QO, (bf16*)(ws + WS_CAT), KB, VT, G, bx, tid););
                XBAR();
                { pg8::Gemm g{(const bf16*)(ws + WS_CAT), (const bf16*)(ws + WS_WO), 1024, 1024, 1024, T1K, 0, 0, T1K, 0, nullptr, 1 << 30}; pg8::EpiRes E{XB, SSQ(cur ^ 1), 1.0f}; GEMM(pg8::EpiRes, g, 192, 4, 1, bx, E); if (REP_RES) { E.alpha = 0.f; GEMM(pg8::EpiRes, g, 192, 4, 1, bx, E); } }
                XBAR();
                cur ^= 1;
            }
        }
    }
    final_phase(X, XB, SSQ(cur), a.in[35], gw, NGW, lane);
#ifdef REP_FINAL
    final_phase(X, XB, SSQ(cur), a.in[35], gw, NGW, lane);
#endif
}

extern "C" void kernel_launch(void* const* d_in, const int* in_sizes, int n_in, void* d_out, int out_size, void* d_ws, size_t ws_size, hipStream_t stream) {
    static int grid = 0;
    if (grid == 0) {
        if (n_in != 36 || out_size != M * D || ws_size < WS_END) { fprintf(stderr, "kernel_launch: unexpected shapes: n_in %d out %d ws %zu (need %zu)\n", n_in, out_size, ws_size, (size_t)WS_END); grid = -1; return; }
        int dev = 0, cus = 0, per_cu = 0;
        hipGetDevice(&dev);
        hipDeviceGetAttribute(&cus, hipDeviceAttributeMultiprocessorCount, dev);
        hipFuncSetAttribute((const void*)mk_fwd, hipFuncAttributeMaxDynamicSharedMemorySize, LDS_BYTES);
        hipOccupancyMaxActiveBlocksPerMultiprocessor(&per_cu, (const void*)mk_fwd, 512, LDS_BYTES);
        (void)hipGetLastError();
        grid = cus;
        if (grid % 8 != 0 || grid < 8) grid = (grid / 8) * 8;
        fprintf(stderr, "kernel_launch: grid %d (occupancy query: %d per CU), ws %zu\n", grid, per_cu, ws_size);
    }
    if (grid <= 0) return;
    Args a{};
    for (int i = 0; i < 36; ++i) a.in[i] = (const float*)d_in[i];
    a.out = (float*)d_out; a.ws = (unsigned char*)d_ws;
    void* args[] = {&a};
    hipError_t e = hipLaunchCooperativeKernel((const void*)mk_fwd, dim3(grid), dim3(512), args, LDS_BYTES, stream);
    if (e != hipSuccess) fprintf(stderr, "kernel_launch: cooperative launch failed: %s (grid %d)\n", hipGetErrorString(e), grid);
}
```

```cpp
#include <hip/hip_runtime.h>
#include <hip/hip_cooperative_groups.h>
#include <cstdio>
#include <cstdint>
namespace cg = cooperative_groups;

__device__ __forceinline__ int opq(int v) { asm volatile("" : "+v"(v)); return v; }

namespace pg8 {
#define PG8_LAS __attribute__((address_space(3)))
typedef unsigned short bf16_t;
typedef short bf16x8 __attribute__((ext_vector_type(8)));
typedef float f32x4 __attribute__((ext_vector_type(4)));
typedef float f32x2 __attribute__((ext_vector_type(2)));
typedef unsigned u32x4 __attribute__((ext_vector_type(4)));
typedef unsigned u32x2 __attribute__((ext_vector_type(2)));
constexpr int BM = 256, BK = 64, HALF = 128, HTB = HALF * BK * 2  , STAGE_BYTES = 8 * HTB, NXCD = 8, WGM = 8;

__host__ __device__ __forceinline__ int lds_byte(int r, int c) { const int st = (r >> 4) * 2 + (c >> 5), rr = r & 15, cc = c & 31, ob = rr * 64 + cc * 2; return st * 1024 + (ob ^ (((ob >> 9) & 1) << 5)); }
__host__ __device__ __forceinline__ void stage_rc(int b, int& R, int& C) { const int st = b / 1024, sb = b % 1024, swz = sb ^ (((sb >> 9) & 1) << 5); R = (st >> 1) * 16 + swz / 64; C = (st & 1) * 32 + (swz % 64) / 2; }
__host__ __device__ __forceinline__ int perm32(int rho) { const int n = rho >> 4, i = rho & 15; return 8 * (i >> 2) + 4 * n + (i & 3); }

struct Unit { int pm, pn, g; };
struct Gemm { const bf16_t* A; const bf16_t* Bt; int lda, ldb, K; size_t a_pm, a_pn, a_g, b_pn, b_g; const bf16_t* A2; int pm2; };

struct Order {
    int nM, nN, nwg, tot, G, c;
    __device__ __forceinline__ void init(int nM_, int nN_, int nG_, int G_, int c_) { nM = nM_; nN = nN_; nwg = nM_ * nN_; tot = nwg * nG_; G = G_; c = c_; }
    __device__ __forceinline__ bool next(int i, Unit& u) const {
        const int L = i * G + c; if (L >= tot) return false;
        if (tot == nwg) {
            int wgid = L; { const int q = nwg / NXCD, r = nwg % NXCD, xcd = wgid % NXCD, off = wgid / NXCD; wgid = (xcd < r ? xcd * (q + 1) : r * (q + 1) + (xcd - r) * q) + off; }
            const int nig = WGM * nN, gid = wgid / nig, fm = gid * WGM, gsz = (nM - fm) < WGM ? (nM - fm) : WGM;
            u.pm = fm + ((wgid % nig) % gsz); u.pn = (wgid % nig) / gsz; u.g = 0;
        } else { u.g = L / nwg; const int r = L % nwg; u.pm = r / nN; u.pn = r % nN; }
        return true;
    }
    __device__ __forceinline__ void a_ready(const Unit&) const {}
    __device__ __forceinline__ void done(const Unit&) const {}
};

typedef __bf16 bf16x2_t __attribute__((ext_vector_type(2)));
__device__ __forceinline__ unsigned cvt_pk_bf16(float lo, float hi) { const f32x2 v = {lo, hi}; const bf16x2_t b = __builtin_convertvector(v, bf16x2_t); return __builtin_bit_cast(unsigned, b); }
__device__ __forceinline__ u32x4 pack8(const f32x4 a, const f32x4 b) { u32x4 w; w.x = cvt_pk_bf16(a[0], a[1]); w.y = cvt_pk_bf16(a[2], a[3]); w.z = cvt_pk_bf16(b[0], b[1]); w.w = cvt_pk_bf16(b[2], b[3]); return w; }
__device__ __forceinline__ float bf_lo(unsigned w) { return __uint_as_float(w << 16); }
__device__ __forceinline__ float bf_hi(unsigned w) { return __uint_as_float(w & 0xffff0000u); }
__device__ __forceinline__ float sigm(float x) { return __builtin_amdgcn_rcpf(1.0f + __builtin_amdgcn_exp2f(-1.4426950408889634f * x)); }
__device__ __forceinline__ float silu_f(float x) { return x * sigm(x); }
__device__ __forceinline__ float gelu_t(float x) { return x * sigm(1.5957691216057308f * (x + 0.044715f * x * x * x)); }
__device__ __forceinline__ f32x4 gelu4(const f32x4 x) { f32x4 t = (x * x * 0.044715f + 1.0f) * x * (-1.5957691216057308f * 1.4426950408889634f);
    _Pragma("unroll") for (int e = 0; e < 4; ++e) t[e] = __builtin_amdgcn_exp2f(t[e]);
    t += 1.0f;
    _Pragma("unroll") for (int e = 0; e < 4; ++e) t[e] = __builtin_amdgcn_rcpf(t[e]);
    return x * t; }
__device__ __forceinline__ float fq_sum(float v) {
    auto r16 = __builtin_amdgcn_permlane16_swap(__float_as_uint(v), __float_as_uint(v), false, false); v = __uint_as_float(r16[0]) + __uint_as_float(r16[1]);
    auto r32 = __builtin_amdgcn_permlane32_swap(__float_as_uint(v), __float_as_uint(v), false, false); return __uint_as_float(r32[0]) + __uint_as_float(r32[1]); }
__device__ __forceinline__ float row_rs16(const float* part, int row, int fq) {
    const f32x4 v = *(const f32x4*)(part + (size_t)row * 16 + fq * 4);
    float s = (v[0] + v[1]) + (v[2] + v[3]); s += __shfl_xor(s, 16); s += __shfl_xor(s, 32);
    return __builtin_amdgcn_rsqf(s * (1.0f / 1024.0f) + 1e-6f);
}
#define EPI_ROWS(...) _Pragma("unroll") for (int ai = 0; ai < 2; ++ai) _Pragma("unroll") for (int m = 0; m < 4; ++m) { const int row = u.pm * BM + ai * HALF + wr * 64 + m * 16 + fr; __VA_ARGS__ }

#define EPI_RS8(part_) float rsv[2][4]; { f32x4 pq_[2][4]; \
    _Pragma("unroll") for (int ai = 0; ai < 2; ++ai) _Pragma("unroll") for (int m = 0; m < 4; ++m) pq_[ai][m] = *(const f32x4*)((part_) + (size_t)(u.pm * BM + ai * HALF + wr * 64 + m * 16 + fr) * 16 + fq * 4); \
    _Pragma("unroll") for (int ai = 0; ai < 2; ++ai) _Pragma("unroll") for (int m = 0; m < 4; ++m) rsv[ai][m] = (pq_[ai][m][0] + pq_[ai][m][1]) + (pq_[ai][m][2] + pq_[ai][m][3]); \
    _Pragma("unroll") for (int ai = 0; ai < 2; ++ai) _Pragma("unroll") for (int m = 0; m < 4; ++m) rsv[ai][m] = fq_sum(rsv[ai][m]); \
    _Pragma("unroll") for (int ai = 0; ai < 2; ++ai) _Pragma("unroll") for (int m = 0; m < 4; ++m) rsv[ai][m] = __builtin_amdgcn_rsqf(rsv[ai][m] * (1.0f / 1024.0f) + 1e-6f); }
struct EpiSwiGLU {
    static constexpr bool PERM = true, AFTER_DRAIN = false;
    bf16_t* H; bf16_t* H2; const float* part;
    __device__ __forceinline__ void operator()(const f32x4 (&acc)[2][2][4][2], const Unit& u, int wr, int wc, int fr, int fq) const {
        const int col = u.pn * HALF + wc * 32 + fq * 8;
        bf16_t* hb = u.pm < 128 ? H : H2 - (size_t)32768 * 4096;
        EPI_RS8(part)
        EPI_ROWS(
            const float rs = rsv[ai][m];
            const f32x4 g0 = acc[ai][0][m][0] * rs, g1 = acc[ai][0][m][1] * rs, u0 = acc[ai][1][m][0] * rs, u1 = acc[ai][1][m][1] * rs;
            f32x4 e0 = g0 * -1.4426950408889634f, e1 = g1 * -1.4426950408889634f;
            _Pragma("unroll") for (int e = 0; e < 4; ++e) { e0[e] = __builtin_amdgcn_exp2f(e0[e]); e1[e] = __builtin_amdgcn_exp2f(e1[e]); }
            e0 += 1.0f; e1 += 1.0f;
            _Pragma("unroll") for (int e = 0; e < 4; ++e) { e0[e] = __builtin_amdgcn_rcpf(e0[e]); e1[e] = __builtin_amdgcn_rcpf(e1[e]); }
            const f32x4 h0 = (g0 * u0) * e0, h1 = (g1 * u1) * e1;
            __builtin_nontemporal_store(pack8(h0, h1), (u32x4*)(hb + (size_t)row * 4096 + col));
        )
    }
};
struct EpiRes {
    static constexpr bool PERM = true, AFTER_DRAIN = false;
    bf16_t* xb; float* part_out; float alpha;
    __device__ __forceinline__ void operator()(const f32x4 (&acc)[2][2][4][2], const Unit& u, int wr, int wc, int fr, int fq) const {
        const int col0 = u.pn * BM + wc * 32 + fq * 8;
#pragma unroll
        for (int ai = 0; ai < 2; ++ai) {
            u32x4 xv[4][2];
#pragma unroll
            for (int m = 0; m < 4; ++m)
#pragma unroll
                for (int bj = 0; bj < 2; ++bj) xv[m][bj] = *(const u32x4*)(xb + (size_t)(u.pm * BM + ai * HALF + wr * 64 + m * 16 + fr) * 1024 + col0 + bj * HALF);
#pragma unroll
            for (int m = 0; m < 4; ++m) {
                const int row = u.pm * BM + ai * HALF + wr * 64 + m * 16 + fr;
                float ss = 0.f;
#pragma unroll
                for (int bj = 0; bj < 2; ++bj) {
                    const u32x4 w = xv[m][bj];
                    f32x4 v0 = (f32x4){bf_lo(w.x), bf_hi(w.x), bf_lo(w.y), bf_hi(w.y)}; f32x4 v1 = (f32x4){bf_lo(w.z), bf_hi(w.z), bf_lo(w.w), bf_hi(w.w)};
                    v0 += acc[ai][bj][m][0] * alpha; v1 += acc[ai][bj][m][1] * alpha;
                    ss += (v0[0] * v0[0] + v0[1] * v0[1]) + (v0[2] * v0[2] + v0[3] * v0[3]) + (v1[0] * v1[0] + v1[1] * v1[1]) + (v1[2] * v1[2] + v1[3] * v1[3]);
                    *(u32x4*)(xb + (size_t)row * 1024 + col0 + bj * HALF) = pack8(v0, v1);
                }
                ss = fq_sum(ss);
                if (fq == 0) part_out[(size_t)row * 16 + u.pn * 4 + wc] = ss;
            }
            asm volatile("" ::: "memory");
        }
    }
};
struct EpiRowScale {
    static constexpr bool PERM = true, AFTER_DRAIN = false;
    bf16_t* O; int ldc; const float* part;
    __device__ __forceinline__ void operator()(const f32x4 (&acc)[2][2][4][2], const Unit& u, int wr, int wc, int fr, int fq) const {
        const int col0 = u.pn * BM + wc * 32 + fq * 8;
        EPI_RS8(part)
        EPI_ROWS(
            const float rs = rsv[ai][m];
            _Pragma("unroll") for (int bj = 0; bj < 2; ++bj) *(u32x4*)(O + (size_t)row * ldc + col0 + bj * HALF) = pack8(acc[ai][bj][m][0] * rs, acc[ai][bj][m][1] * rs);
        )
    }
};
struct EpiVT {
    static constexpr bool PERM = true, AFTER_DRAIN = false;
    bf16_t* O; const float* rsm;
    __device__ __forceinline__ void operator()(const f32x4 (&acc)[2][2][4][2], const Unit& u, int wr, int wc, int fr, int fq) const {
        const int col0 = u.pn * BM + wc * 32 + fq * 8;
        f32x4 s[2][2];
        _Pragma("unroll") for (int bj = 0; bj < 2; ++bj) { s[bj][0] = *(const f32x4*)(rsm + col0 + bj * HALF); s[bj][1] = *(const f32x4*)(rsm + col0 + bj * HALF + 4); }
        EPI_ROWS(
            _Pragma("unroll") for (int bj = 0; bj < 2; ++bj) *(u32x4*)(O + (size_t)row * 4096 + col0 + bj * HALF) = pack8(acc[ai][bj][m][0] * s[bj][0], acc[ai][bj][m][1] * s[bj][1]);
        )
    }
};
struct EpiWin {
    static constexpr bool PERM = true, AFTER_DRAIN = false;
    bf16_t* AP; bf16_t* ZUB; bf16_t* ZVB; f32x2* lnp; const float* part;
    __device__ __forceinline__ void operator()(const f32x4 (&acc)[2][2][4][2], const Unit& u, int wr, int wc, int fr, int fq) const {
        const int cl = wc * 32 + fq * 8;
        EPI_RS8(part)
        EPI_ROWS(
            const float rs = rsv[ai][m];
            if (u.pn < 2) {
                _Pragma("unroll") for (int bj = 0; bj < 2; ++bj) { const int c = u.pn * BM + bj * HALF + cl; const int g = c >> 4;
                    *(u32x4*)(AP + ((size_t)(g * 1536 + (row >> 5)) * 768 + (row & 31) * 16 + (c & 15))) = pack8(acc[ai][bj][m][0] * rs, acc[ai][bj][m][1] * rs); }
            } else if (u.pn < 4) {
                _Pragma("unroll") for (int bj = 0; bj < 2; ++bj) { const int c = (u.pn - 2) * BM + bj * HALF + cl; f32x4 a = acc[ai][bj][m][0] * rs, b = acc[ai][bj][m][1] * rs;
                    a = gelu4(a); b = gelu4(b);
                    *(u32x4*)(ZUB + (size_t)row * 512 + c) = pack8(a, b); }
            } else {
                float s1 = 0.f, s2 = 0.f;
                _Pragma("unroll") for (int bj = 0; bj < 2; ++bj) { const int c = (u.pn - 4) * BM + bj * HALF + cl; f32x4 a = acc[ai][bj][m][0] * rs, b = acc[ai][bj][m][1] * rs;
                    a = gelu4(a); b = gelu4(b); _Pragma("unroll") for (int e = 0; e < 4; ++e) { s1 += a[e] + b[e]; s2 += a[e] * a[e] + b[e] * b[e]; }
                    *(u32x4*)(ZVB + (size_t)row * 512 + c) = pack8(a, b); }
                s1 = fq_sum(s1); s2 = fq_sum(s2);
                if (fq == 0) lnp[(size_t)row * 8 + (u.pn - 4) * 4 + wc] = (f32x2){s1, s2};
            }
        )
    }
};
struct EpiF32 {
    static constexpr bool PERM = true, AFTER_DRAIN = false;
    float* O; int ldc; int rows_per_g;
    __device__ __forceinline__ void operator()(const f32x4 (&acc)[2][2][4][2], const Unit& u, int wr, int wc, int fr, int fq) const {
        const int col0 = u.pn * BM + wc * 32 + fq * 8;
        EPI_ROWS(
            _Pragma("unroll") for (int bj = 0; bj < 2; ++bj) { float* p = O + ((size_t)u.g * rows_per_g + row) * ldc + col0 + bj * HALF; *(f32x4*)p = acc[ai][bj][m][0]; *(f32x4*)(p + 4) = acc[ai][bj][m][1]; }
        )
    }
};
struct EpiS5aScan {
    static constexpr bool PERM = true, AFTER_DRAIN = true;
    float* SST; bf16_t* AP; const f32x2* APOW;
    __device__ __forceinline__ void fused(f32x4 (&acc)[2][2][4][2], const Unit& u, int wr, int wc, int fr, int fq, PG8_LAS unsigned char* lds, int wid, int lane) const {
        const int col0 = wc * 32 + fq * 8;
        EPI_ROWS(
            _Pragma("unroll") for (int bj = 0; bj < 2; ++bj) { float* p = SST + ((size_t)u.g * 1536 + row) * 256 + col0 + bj * HALF; *(f32x4*)p = acc[ai][bj][m][0]; *(f32x4*)(p + 4) = acc[ai][bj][m][1]; }
        )
        asm volatile("s_waitcnt vmcnt(0)" ::: "memory"); __builtin_amdgcn_s_barrier(); asm volatile("" ::: "memory");
        const int tid = wid * 64 + lane, p = tid & 63, dir = (tid >> 6) & 1, sl = tid >> 7;
        const bool prompt = u.pm < 4; const int nch = prompt ? 128 : 64, ch0 = u.pm * 256 + sl * nch;
        if (prompt && sl >= 2) return;
        const f32x2 a32 = APOW[((size_t)(dir * 32 + u.g) * 33 + 32) * 64 + p];
        const float* S = SST + (size_t)u.g * 1536 * 256 + dir * 128 + p; bf16_t* H = AP + (size_t)u.g * 1536 * 768 + 512 + dir * 128 + p;
        float hr = 0.f, hi = 0.f;
#pragma unroll 8
        for (int i = 0; i < nch; ++i) {
            const int ch = ch0 + (dir == 0 ? i : nch - 1 - i);
            const float sr = S[(size_t)ch * 256], si = S[(size_t)ch * 256 + 64];
            H[(size_t)ch * 768] = (bf16_t)(cvt_pk_bf16(hr, 0.f) & 0xffffu); H[(size_t)ch * 768 + 64] = (bf16_t)(cvt_pk_bf16(hi, 0.f) & 0xffffu);
            const float nr = a32.x * hr - a32.y * hi + sr, ni = a32.x * hi + a32.y * hr + si; hr = nr; hi = ni;
        }
    }
};
struct EpiS5c {
    static constexpr bool PERM = true, AFTER_DRAIN = false;
    bf16_t* G;
    __device__ __forceinline__ void operator()(const f32x4 (&acc)[2][2][4][2], const Unit& u, int wr, int wc, int fr, int fq) const {
        const int col0 = u.pn * BM + wc * 32 + fq * 8;
        EPI_ROWS(
            _Pragma("unroll") for (int bj = 0; bj < 2; ++bj) { const int col = col0 + bj * HALF; const int t = col >> 4, c = col & 15; f32x4 a = acc[ai][bj][m][0], b = acc[ai][bj][m][1];
                a = gelu4(a); b = gelu4(b);
                *(u32x4*)(G + ((size_t)(row * 32 + t) * 512 + u.g * 16 + c)) = pack8(a, b); }
        )
    }
};
struct EpiGLU {
    static constexpr bool PERM = true, AFTER_DRAIN = false;
    const bf16_t* G; bf16_t* CAT;
    __device__ __forceinline__ void operator()(const f32x4 (&acc)[2][2][4][2], const Unit& u, int wr, int wc, int fr, int fq) const {
        const int col0 = u.pn * BM + wc * 32 + fq * 8;
        EPI_ROWS(
            _Pragma("unroll") for (int bj = 0; bj < 2; ++bj) { const int col = col0 + bj * HALF; const u32x4 gv = *(const u32x4*)(G + (size_t)row * 512 + col);
                f32x4 a, b; a[0] = bf_lo(gv.x) * sigm(acc[ai][bj][m][0][0]); a[1] = bf_hi(gv.x) * sigm(acc[ai][bj][m][0][1]); a[2] = bf_lo(gv.y) * sigm(acc[ai][bj][m][0][2]); a[3] = bf_hi(gv.y) * sigm(acc[ai][bj][m][0][3]);
                b[0] = bf_lo(gv.z) * sigm(acc[ai][bj][m][1][0]); b[1] = bf_hi(gv.z) * sigm(acc[ai][bj][m][1][1]); b[2] = bf_lo(gv.w) * sigm(acc[ai][bj][m][1][2]); b[3] = bf_hi(gv.w) * sigm(acc[ai][bj][m][1][3]);
                *(u32x4*)(CAT + (size_t)row * 1024 + col) = pack8(a, b); }
        )
    }
};

template <class Epi, class Sched, bool ALIGN_EPI = false, bool SP2 = false>
__device__ __forceinline__ void gemm_phase(PG8_LAS unsigned char* lds, const Gemm g, const Sched& S, const Epi& E) {
    const int tid = opq((int)threadIdx.x), wid = __builtin_amdgcn_readfirstlane(tid >> 6), lane = tid & 63, wr = wid >> 2, wc = wid & 3, fr = lane & 15, fq = lane >> 4;
    const int K = g.K, nt = K / BK, lda = g.lda, ldb = g.ldb;
    unsigned voffA[2], voffB[2];
#pragma unroll
    for (int i = 0; i < 2; ++i) { int R, C; stage_rc(tid * 16 + i * 8192, R, C); const int Rb = Epi::PERM ? ((R & ~31) + perm32(R & 31)) : R;
        voffA[i] = (unsigned)(R * lda + C) * 2u; voffB[i] = (unsigned)(Rb * ldb + C) * 2u; }
    const size_t kstep = (size_t)(BK * 2);
    const size_t hstepA = (size_t)HALF * lda * 2, hstepB = (size_t)HALF * ldb * 2;
    const unsigned ldsw = (unsigned)wid * 1024u;
    const int aoff = lds_byte(wr * 64 + fr, fq * 8), boff = lds_byte(wc * 32 + fr, fq * 8);
#define PG8_SA(b, h) (((b) * 2 + (h)) * HTB)
#define PG8_SB(b, h) ((4 + (b) * 2 + (h)) * HTB)
#define PG8_STAGE(bufoff, gbase, voff) do { _Pragma("unroll") for (int _i = 0; _i < 2; ++_i) \
        __builtin_amdgcn_global_load_lds((const unsigned*)((const char*)(gbase) + (voff)[_i]), (PG8_LAS unsigned*)(lds + (bufoff) + ldsw + _i * 8192), 16, 0, 0); } while (0)
#define PG8_LDA(dst, b, h) do { _Pragma("unroll") for (int m = 0; m < 4; ++m) _Pragma("unroll") for (int k = 0; k < 2; ++k) dst[m][k] = *(const PG8_LAS bf16x8*)(lds + PG8_SA(b, h) + aoff + m * 2048 + k * 1024); } while (0)
#define PG8_LDB(dst, b, h) do { _Pragma("unroll") for (int n = 0; n < 2; ++n) _Pragma("unroll") for (int k = 0; k < 2; ++k) dst[n][k] = *(const PG8_LAS bf16x8*)(lds + PG8_SB(b, h) + boff + n * 2048 + k * 1024); } while (0)
#define PG8_MMA(ai, bj, At, Bt) do { __builtin_amdgcn_s_setprio(1); _Pragma("unroll") for (int m = 0; m < 4; ++m) _Pragma("unroll") for (int n = 0; n < 2; ++n) _Pragma("unroll") for (int k = 0; k < 2; ++k) \
        acc[ai][bj][m][n] = __builtin_amdgcn_mfma_f32_16x16x32_bf16(Bt[n][k], At[m][k], acc[ai][bj][m][n], 0, 0, 0); __builtin_amdgcn_s_setprio(0); } while (0)
#define PG8_WAIT_V(n) asm volatile("s_waitcnt vmcnt(" #n ")" ::: "memory")
#define PG8_WAIT_L(n) asm volatile("s_waitcnt lgkmcnt(" #n ")" ::: "memory")
#define PG8_BAR __builtin_amdgcn_s_barrier()
#define PG8_SCHED __builtin_amdgcn_sched_barrier(0)
    Unit cur, nxt; int ui = 0;
    if (!S.next(0, cur)) return;
    f32x4 acc[2][2][4][2];
#pragma unroll
    for (int a = 0; a < 2; ++a)
#pragma unroll
        for (int b = 0; b < 2; ++b)
#pragma unroll
            for (int m = 0; m < 4; ++m)
#pragma unroll
                for (int n = 0; n < 2; ++n) acc[a][b][m][n] = (f32x4){0.f, 0.f, 0.f, 0.f};
    bf16x8 At[4][2], B0[2][2], B1[2][2];
    const char* cA = (cur.pm < g.pm2 ? (const char*)g.A + (size_t)cur.pm * g.a_pm : (const char*)g.A2 + (size_t)(cur.pm - g.pm2) * g.a_pm) + (size_t)cur.pn * g.a_pn + (size_t)cur.g * g.a_g; const char* cB = (const char*)g.Bt + (size_t)cur.pn * g.b_pn + (size_t)cur.g * g.b_g;
    S.a_ready(cur);
    if constexpr (SP2) {
        PG8_STAGE(PG8_SB(0, 0), cB, voffB); PG8_STAGE(PG8_SB(0, 1), cB + hstepB, voffB); PG8_STAGE(PG8_SA(0, 0), cA, voffA); PG8_STAGE(PG8_SA(0, 1), cA + hstepA, voffA);
        if (wr == 1) PG8_BAR;
        PG8_WAIT_V(2); PG8_BAR;
        PG8_STAGE(PG8_SB(1, 0), cB + kstep, voffB); PG8_STAGE(PG8_SA(1, 0), cA + kstep, voffA); PG8_STAGE(PG8_SB(1, 1), cB + hstepB + kstep, voffB);
        PG8_WAIT_V(6); PG8_BAR;
    } else {
        PG8_STAGE(PG8_SB(0, 0), cB, voffB); PG8_STAGE(PG8_SA(0, 0), cA, voffA); PG8_STAGE(PG8_SB(0, 1), cB + hstepB, voffB); PG8_STAGE(PG8_SA(0, 1), cA + hstepA, voffA);
        if (wr == 1) PG8_BAR;
        PG8_WAIT_V(4); PG8_BAR;
        PG8_STAGE(PG8_SB(1, 0), cB + kstep, voffB); PG8_STAGE(PG8_SA(1, 0), cA + kstep, voffA); PG8_STAGE(PG8_SB(1, 1), cB + hstepB + kstep, voffB);
        PG8_WAIT_V(6); PG8_BAR;
    }
    for (;;) {
        const bool has_next = S.next(ui + 1, nxt);
        const char* nA = has_next ? (nxt.pm < g.pm2 ? (const char*)g.A + (size_t)nxt.pm * g.a_pm : (const char*)g.A2 + (size_t)(nxt.pm - g.pm2) * g.a_pm) + (size_t)nxt.pn * g.a_pn + (size_t)nxt.g * g.a_g : cA; const char* nB = has_next ? (const char*)g.Bt + (size_t)nxt.pn * g.b_pn + (size_t)nxt.g * g.b_g : cB;
        for (int t = 0; t < nt; t += 2) {
            const bool last = (t == nt - 2);
            const char* a1 = cA + (size_t)(t + 1) * kstep;
            const char* a2 = last ? nA : cA + (size_t)(t + 2) * kstep; const char* b2 = last ? nB : cB + (size_t)(t + 2) * kstep;
            const char* a3 = a2 + kstep; const char* b3 = b2 + kstep;
            if (last && has_next) S.a_ready(nxt);
            if constexpr (SP2) {
            PG8_LDB(B0, 0, 0); PG8_LDB(B1, 0, 1); PG8_SCHED; PG8_LDA(At, 0, 0); PG8_STAGE(PG8_SA(1, 1), a1 + hstepA, voffA);
            PG8_WAIT_V(8); PG8_WAIT_L(0); PG8_BAR; PG8_MMA(0, 0, At, B0); PG8_MMA(0, 1, At, B1); PG8_BAR; PG8_SCHED;
            PG8_LDA(At, 0, 1); PG8_STAGE(PG8_SB(0, 0), b2, voffB); PG8_STAGE(PG8_SB(0, 1), b2 + hstepB, voffB); PG8_STAGE(PG8_SA(0, 0), a2, voffA);
            PG8_WAIT_V(8); PG8_WAIT_L(0); PG8_BAR; PG8_MMA(1, 0, At, B0); PG8_MMA(1, 1, At, B1); PG8_BAR; PG8_SCHED;
            PG8_LDB(B0, 1, 0); PG8_LDB(B1, 1, 1); PG8_SCHED; PG8_LDA(At, 1, 0); PG8_STAGE(PG8_SA(0, 1), a2 + hstepA, voffA);
            PG8_WAIT_V(8); PG8_WAIT_L(0); PG8_BAR; PG8_MMA(0, 0, At, B0); PG8_MMA(0, 1, At, B1); PG8_BAR; PG8_SCHED;
            PG8_LDA(At, 1, 1); PG8_STAGE(PG8_SB(1, 0), b3, voffB); PG8_STAGE(PG8_SB(1, 1), b3 + hstepB, voffB); PG8_STAGE(PG8_SA(1, 0), a3, voffA);
            PG8_WAIT_V(8); PG8_WAIT_L(0); PG8_BAR; PG8_MMA(1, 0, At, B0); PG8_MMA(1, 1, At, B1); PG8_BAR; PG8_SCHED;
            } else {
            PG8_LDB(B0, 0, 0); PG8_SCHED; PG8_LDA(At, 0, 0); PG8_STAGE(PG8_SA(1, 1), a1 + hstepA, voffA);
            PG8_WAIT_L(8); PG8_BAR; PG8_WAIT_L(0); PG8_MMA(0, 0, At, B0); PG8_BAR; PG8_SCHED;
            PG8_LDB(B1, 0, 1); PG8_STAGE(PG8_SB(0, 0), b2, voffB);
            PG8_BAR; PG8_WAIT_L(0); PG8_MMA(0, 1, At, B1); PG8_BAR;
            PG8_LDA(At, 0, 1); PG8_STAGE(PG8_SA(0, 0), a2, voffA);
            PG8_BAR; PG8_WAIT_L(0); PG8_MMA(1, 0, At, B0); PG8_BAR; PG8_SCHED;
            PG8_STAGE(PG8_SB(0, 1), b2 + hstepB, voffB);
            PG8_WAIT_V(6); PG8_BAR; PG8_MMA(1, 1, At, B1); PG8_BAR;
            PG8_LDB(B0, 1, 0); PG8_SCHED; PG8_LDA(At, 1, 0); PG8_STAGE(PG8_SA(0, 1), a2 + hstepA, voffA);
            PG8_WAIT_L(8); PG8_BAR; PG8_WAIT_L(0); PG8_MMA(0, 0, At, B0); PG8_BAR; PG8_SCHED;
            PG8_LDB(B1, 1, 1); PG8_STAGE(PG8_SB(1, 0), b3, voffB);
            PG8_BAR; PG8_WAIT_L(0); PG8_MMA(0, 1, At, B1); PG8_BAR;
            PG8_LDA(At, 1, 1); PG8_STAGE(PG8_SA(1, 0), a3, voffA);
            PG8_BAR; PG8_WAIT_L(0); PG8_MMA(1, 0, At, B0); PG8_BAR; PG8_SCHED;
            PG8_STAGE(PG8_SB(1, 1), b3 + hstepB, voffB);
            PG8_WAIT_V(6); PG8_BAR; PG8_MMA(1, 1, At, B1); PG8_BAR;
            }
        }
        if constexpr (ALIGN_EPI) { if (wr == 0) PG8_BAR; }
        if constexpr (!Epi::AFTER_DRAIN) { E(acc, cur, wr, wc, fr, fq); S.done(cur); }
        if (!has_next) break;
#pragma unroll
        for (int a = 0; a < 2; ++a)
#pragma unroll
            for (int b = 0; b < 2; ++b)
#pragma unroll
                for (int m = 0; m < 4; ++m)
#pragma unroll
                    for (int n = 0; n < 2; ++n) acc[a][b][m][n] = (f32x4){0.f, 0.f, 0.f, 0.f};
        cur = nxt; cA = nA; cB = nB; ++ui;
        if constexpr (ALIGN_EPI) { if (wr == 1) PG8_BAR; }
    }
    PG8_WAIT_V(0);
    if constexpr (!ALIGN_EPI) { if (wr == 0) PG8_BAR; }
    PG8_BAR;
    if constexpr (Epi::AFTER_DRAIN) { E.fused(acc, cur, wr, wc, fr, fq, lds, wid, lane); S.done(cur); }
#undef PG8_SA
#undef PG8_SB
#undef PG8_STAGE
#undef PG8_LDA
#undef PG8_LDB
#undef PG8_MMA
#undef PG8_WAIT_V
#undef PG8_WAIT_L
#undef PG8_BAR
#undef PG8_SCHED
}
}

#define LAS __attribute__((address_space(3)))
typedef unsigned short bf16;
typedef unsigned v4u __attribute__((ext_vector_type(4)));
typedef unsigned v2u __attribute__((ext_vector_type(2)));
typedef float f32x4 __attribute__((ext_vector_type(4)));
typedef float f32x2 __attribute__((ext_vector_type(2)));
typedef short bf16x8 __attribute__((ext_vector_type(8)));
using pg8::cvt_pk_bf16; using pg8::bf_lo; using pg8::bf_hi;

constexpr int M = 49152, D = 1024, FF = 4096, NSPLIT = 3, SROWS = M / NSPLIT;
constexpr int LDS_BYTES = 147456;
constexpr size_t MiB = (size_t)1 << 20;
constexpr size_t WS_SSQ0 = 1 * MiB, WS_SSQ1 = 4 * MiB, WS_LNP = 7 * MiB, WS_RSM = 10 * MiB, WS_SSQM = 10 * MiB + 256 * 1024, WS_APOW = 11 * MiB, WS_BBAR = 13 * MiB, WS_WSB = 13 * MiB + 512 * 1024, WS_KTAB = 14 * MiB;
constexpr size_t WS_WGU1 = 16 * MiB, WS_WGU2 = 32 * MiB, WS_WD1 = 48 * MiB, WS_WD2 = 56 * MiB, WS_WQ = 64 * MiB, WS_WKV = 66 * MiB, WS_WO = 70 * MiB, WS_WIN = 72 * MiB, WS_WGLU = 75 * MiB, WS_WOUT = 76 * MiB, WS_WPOOL = 78 * MiB;
constexpr size_t WS_XB = 88 * MiB, WS_MEMB = 184 * MiB, WS_KB = 192 * MiB, WS_VT = 200 * MiB;
constexpr size_t WS_H = 208 * MiB, WS_QO = 208 * MiB, WS_POOLED = 208 * MiB, WS_ZUB = 208 * MiB, WS_ZVB = 256 * MiB, WS_SST = 304 * MiB, WS_GB = 352 * MiB, WS_AP = 400 * MiB, WS_BT = 472 * MiB, WS_B1S = 496 * MiB, WS_CAT = 400 * MiB, WS_END = 504 * MiB;

struct Args { const float* in[36]; float* out; unsigned char* ws; };

#define LDS_WAIT() asm volatile("s_waitcnt lgkmcnt(0)" ::: "memory")
__device__ __forceinline__ float wave_sum(float v) {
#pragma unroll
    for (int o = 1; o < 64; o <<= 1) v += __shfl_xor(v, o);
    return v;
}
__device__ __forceinline__ unsigned short f2bf(float f) { return (unsigned short)(cvt_pk_bf16(f, 0.f) & 0xffffu); }
__device__ __forceinline__ float rsq_eps(float ssq) { return __builtin_amdgcn_rsqf(ssq * (1.0f / 1024.0f) + 1e-6f); }

struct TD { const float* W; const float* gk; const float* gn; bf16* WT; int ldw, k0, n0, ldt, drow_off, mode; float scale; };
__device__ __forceinline__ void td_load(const TD& d, int tid, f32x4 (&v)[8]) {
#pragma unroll
    for (int i = 0; i < 8; ++i) { const int idx = tid + 512 * i, kk = idx >> 6, c4 = idx & 63; v[i] = __builtin_nontemporal_load((const f32x4*)(d.W + (size_t)(d.k0 + kk) * d.ldw + d.n0 + c4 * 4)); }
}
__device__ __forceinline__ void td_store(const TD& d, int tid, const f32x4 (&v)[8], LAS float* scr) {
#pragma unroll
    for (int i = 0; i < 8; ++i) { const int idx = tid + 512 * i, kk = idx >> 6, c4 = idx & 63; const float g = d.gk ? d.gk[d.k0 + kk] : 1.0f;
#pragma unroll
        for (int e = 0; e < 4; ++e) { const int n = c4 * 4 + e; scr[kk * 257 + (n ^ ((n >> 5) & 3))] = v[i][e] * g; } }
    __syncthreads();
#pragma unroll
    for (int j = 0; j < 4; ++j) {
        const int n = (tid >> 2) + 128 * (j >> 1), c = (tid & 3) + 4 * (j & 1), ng = d.n0 + n; const float sc = d.gn ? d.scale * d.gn[ng] : d.scale;
        const LAS float* s = scr + (8 * c) * 257 + (n ^ ((n >> 5) & 3));
        v4u o; o.x = cvt_pk_bf16(s[0 * 257] * sc, s[1 * 257] * sc); o.y = cvt_pk_bf16(s[2 * 257] * sc, s[3 * 257] * sc); o.z = cvt_pk_bf16(s[4 * 257] * sc, s[5 * 257] * sc); o.w = cvt_pk_bf16(s[6 * 257] * sc, s[7 * 257] * sc);
        const int drow = d.mode == 0 ? ng : ((ng >> 7) * 256 + (ng & 127) + (d.mode == 2 ? 128 : 0));
        *(v4u*)(d.WT + (size_t)(d.drow_off + drow) * d.ldt + d.k0 + 8 * c) = o;
    }
    __syncthreads();
}
#define TDS(W_, K_, N_, GK_, SC_, WT_, MODE_) { constexpr int nblk_ = (N_) / 256, cnt_ = ((K_) / 64) * nblk_; if (r < cnt_) { d.W = (W_); d.ldw = (N_); d.k0 = 64 * (r / nblk_); d.n0 = 256 * (r % nblk_); d.gk = (GK_); d.gn = nullptr; d.scale = (SC_); d.WT = (WT_); d.ldt = (K_); d.drow_off = 0; d.mode = (MODE_); return; } r -= cnt_; }
__device__ __forceinline__ void td_desc(const Args& a, unsigned char* ws, int l, int r, TD& d) {
    const size_t LW = (size_t)1024 * 4096;
    const float* g_f1 = a.in[4] + l * 1024; const float* g_f2 = a.in[31] + l * 1024; const float* g_cr = a.in[26] + l * 1024; const float* g_mem = a.in[27] + l * 1024;
    TDS(a.in[5] + l * LW, 1024, 4096, g_f1, 1.0f, (bf16*)(ws + WS_WGU1), 1)
    TDS(a.in[6] + l * LW, 1024, 4096, g_f1, 1.0f, (bf16*)(ws + WS_WGU1), 2)
    TDS(a.in[7] + l * LW, 4096, 1024, nullptr, 1.0f, (bf16*)(ws + WS_WD1), 0)
    TDS(a.in[32] + l * LW, 1024, 4096, g_f2, 1.0f, (bf16*)(ws + WS_WGU2), 1)
    TDS(a.in[33] + l * LW, 1024, 4096, g_f2, 1.0f, (bf16*)(ws + WS_WGU2), 2)
    TDS(a.in[34] + l * LW, 4096, 1024, nullptr, 1.0f, (bf16*)(ws + WS_WD2), 0)
    TDS(a.in[28] + (size_t)l * 1024 * 1024, 1024, 1024, g_cr, 0.0625f * 1.4426950408889634f, (bf16*)(ws + WS_WQ), 0)
    TDS(a.in[29] + (size_t)l * 1024 * 2048, 1024, 2048, g_mem, 1.0f, (bf16*)(ws + WS_WKV), 0)
    TDS(a.in[30] + (size_t)l * 1024 * 1024, 1024, 1024, nullptr, 1.0f, (bf16*)(ws + WS_WO), 0)
    if (l == 0) {
        TDS(a.in[9], 1024, 1536, a.in[8], 1.0f, (bf16*)(ws + WS_WIN), 0)
        TDS(a.in[18], 512, 512, nullptr, 1.0f, (bf16*)(ws + WS_WGLU), 0)
        TDS(a.in[23], 1024, 1024, nullptr, 1.0f, (bf16*)(ws + WS_WOUT), 0)
    }
    { const int gi = (r >> 2) & 3, kb = r & 3;
      d.W = a.in[24] + (size_t)gi * 65536; d.ldw = 256; d.k0 = 64 * kb; d.n0 = 0; d.gk = a.in[8] + 1024 + gi * 256; d.gn = a.in[25] + gi * 256; d.scale = 1.0f; d.WT = (bf16*)(ws + WS_WPOOL); d.ldt = 256; d.drow_off = gi * 256; d.mode = 0; }
}
__device__ __forceinline__ void prep_weights(const Args& a, unsigned char* ws, LAS unsigned char* lds, int l, int bx, int G, int tid, int sel) {
    tid = opq(tid);
    LAS float* scr = (LAS float*)lds;
    const int nall = 6 * 256 + 64 + 128 + 64 + (l == 0 ? 96 + 16 + 64 : 16);
    const int nitems = sel == 0 ? nall : sel == 1 ? 768 + (nall - 1536) : sel == 2 ? 512 : 256;
#define PW_MAP(i_) (sel == 0 ? (i_) : sel == 1 ? ((i_) < 768 ? (i_) : (i_) + 768) : sel == 2 ? (i_) + 768 : (i_) + 1280)
    int it = bx; if (it >= nitems) return;
    TD cur; td_desc(a, ws, l, PW_MAP(it), cur);
    f32x4 v[8]; td_load(cur, tid, v);
    for (;;) {
        const int itn = it + G; const bool more = itn < nitems;
        TD nxt = cur; f32x4 vn[8];
        if (more) { td_desc(a, ws, l, PW_MAP(itn), nxt); td_load(nxt, tid, vn); }
        td_store(cur, tid, v, scr);
        if (!more) break;
#pragma unroll
        for (int i = 0; i < 8; ++i) v[i] = vn[i];
        cur = nxt; it = itn;
    }
#undef PW_MAP
}

__device__ __forceinline__ void sincos_turns(double t, double& c, double& s) {
    t -= __builtin_rint(t);
    const double n = __builtin_rint(4.0 * t); const double r = t - 0.25 * n; const double x = 6.283185307179586476925 * r, x2 = x * x;
    double sp = -7.647163731819816e-13; sp = sp * x2 + 1.605904383682161e-10; sp = sp * x2 - 2.505210838544172e-08; sp = sp * x2 + 2.755731922398589e-06; sp = sp * x2 - 1.984126984126984e-04; sp = sp * x2 + 8.333333333333333e-03; sp = sp * x2 - 1.666666666666667e-01; sp = sp * x2 * x + x;
    double cp = 4.779477332387385e-14; cp = cp * x2 - 1.147074559772972e-11; cp = cp * x2 + 2.087675698786810e-09; cp = cp * x2 - 2.755731922398589e-07; cp = cp * x2 + 2.480158730158730e-05; cp = cp * x2 - 1.388888888888889e-03; cp = cp * x2 + 4.166666666666666e-02; cp = cp * x2 - 0.5; cp = cp * x2 + 1.0;
    const int q = ((int)n) & 3;
    c = (q == 0) ? cp : (q == 1) ? -sp : (q == 2) ? -cp : sp;
    s = (q == 0) ? sp : (q == 1) ? cp : (q == 2) ? -sp : -cp;
}
__device__ __forceinline__ void prep_misc(const Args& a, unsigned char* ws, int gw, int NGW, int gt, int NT, int lane) {
    gw = opq(gw); gt = opq(gt); lane = opq(lane);
    bf16* XB = (bf16*)(ws + WS_XB); float* SSQ0 = (float*)(ws + WS_SSQ0);
    for (int r0 = gw; r0 < M; r0 += 4 * NGW) {
        f32x4 v[4][4];
#pragma unroll
        for (int q = 0; q < 4; ++q) { const int r = r0 + q * NGW < M ? r0 + q * NGW : r0; const float* src = r < 32768 ? a.in[0] + (size_t)r * D : a.in[1] + (size_t)(r - 32768) * D;
#pragma unroll
            for (int j = 0; j < 4; ++j) v[q][j] = __builtin_nontemporal_load((const f32x4*)src + lane + 64 * j); }
#pragma unroll
        for (int q = 0; q < 4; ++q) { const int r = r0 + q * NGW < M ? r0 + q * NGW : r0; float s = 0.f;
#pragma unroll
            for (int j = 0; j < 4; ++j) { const f32x4 x = v[q][j]; s += (x[0] * x[0] + x[1] * x[1]) + (x[2] * x[2] + x[3] * x[3]);
                v2u w; w.x = cvt_pk_bf16(x[0], x[1]); w.y = cvt_pk_bf16(x[2], x[3]); ((v2u*)(XB + (size_t)r * D))[lane + 64 * j] = w; }
            s = wave_sum(s);
            if (lane < 16) SSQ0[(size_t)r * 16 + lane] = lane == 0 ? s : 0.f; }
    }
    bf16* MEMB = (bf16*)(ws + WS_MEMB); float* SSQM = (float*)(ws + WS_SSQM); float* RSM = (float*)(ws + WS_RSM);
    for (int r = gw; r < 4096; r += NGW) {
        const float* src = r < 2048 ? a.in[2] + (size_t)r * D : a.in[3] + (size_t)(r - 2048) * D;
        float s = 0.f;
#pragma unroll
        for (int j = 0; j < 4; ++j) { const f32x4 v = __builtin_nontemporal_load((const f32x4*)src + lane + 64 * j); s += (v[0] * v[0] + v[1] * v[1]) + (v[2] * v[2] + v[3] * v[3]);
            v2u w; w.x = cvt_pk_bf16(v[0], v[1]); w.y = cvt_pk_bf16(v[2], v[3]); ((v2u*)(MEMB + (size_t)r * D))[lane + 64 * j] = w; }
        s = wave_sum(s);
        if (lane < 16) SSQM[(size_t)r * 16 + lane] = lane == 0 ? s : 0.f;
        if (lane == 0) RSM[r] = rsq_eps(s);
    }
    { bf16* WSB = (bf16*)(ws + WS_WSB); for (int i = gt; i < 4 * 128 * 128; i += NT) WSB[i] = f2bf(a.in[21][i]); }
    f32x2* APOW = (f32x2*)(ws + WS_APOW); f32x2* BBAR = (f32x2*)(ws + WS_BBAR);
    for (int idx = gt; idx < 2 * 32 * 64; idx += NT) {
        const int p = idx & 63, dg = idx >> 6;
        const double lre = (double)a.in[10][idx], lim = (double)a.in[11][idx]; const double dt = exp((double)a.in[12][dg]);
        const double lr = lre * dt, tn = lim * dt * 0.15915494309189533577;
        double a1r = 0., a1i = 0.;
        for (int k = 0; k <= 32; ++k) { const double mag = exp((double)k * lr); double c, s; sincos_turns((double)k * tn, c, s); APOW[((size_t)dg * 33 + k) * 64 + p] = (f32x2){(float)(mag * c), (float)(mag * s)}; if (k == 1) { a1r = mag * c; a1i = mag * s; } }
        const double nr = a1r - 1.0, ni = a1i, den = lre * lre + lim * lim; const double qr = (nr * lre + ni * lim) / den, qi = (ni * lre - nr * lim) / den;
#pragma unroll 4
        for (int c = 0; c < 16; ++c) { const double br = (double)a.in[13][(size_t)idx * 16 + c], bi = (double)a.in[14][(size_t)idx * 16 + c]; BBAR[(size_t)idx * 16 + c] = (f32x2){(float)(qr * br - qi * bi), (float)(qr * bi + qi * br)}; }
    }
}
__device__ __forceinline__ void s5_tab2(const Args& a, unsigned char* ws, int gt, int NT) {
    gt = opq(gt);
    const f32x2* APOW = (const f32x2*)(ws + WS_APOW); const f32x2* BBAR = (const f32x2*)(ws + WS_BBAR); float* KTAB = (float*)(ws + WS_KTAB);
    for (int e = gt; e < 32 * 2 * 32 * 256; e += NT) {
        const int cc = e & 15, c = (e >> 4) & 15, k = (e >> 8) & 31, dir = (e >> 13) & 1, g = e >> 14, dg = dir * 32 + g;
        const f32x2* ap = APOW + ((size_t)dg * 33 + k) * 64; const float* cre = a.in[15] + ((size_t)dg * 16 + c) * 64; const float* cim = a.in[16] + ((size_t)dg * 16 + c) * 64; const f32x2* bb = BBAR + (size_t)dg * 1024 + cc;
        float acc = 0.f;
#pragma unroll 8
        for (int p = 0; p < 64; ++p) { const f32x2 av = ap[p]; const float cr = cre[p], ci = cim[p]; const float car = cr * av.x - ci * av.y, cai = cr * av.y + ci * av.x; const f32x2 b = bb[p * 16]; acc += car * b.x - cai * b.y; }
        KTAB[e] = acc;
    }
}
__device__ __forceinline__ void s5_tab3(const Args& a, unsigned char* ws, int gt, int NT) {
    gt = opq(gt);
    const f32x2* APOW = (const f32x2*)(ws + WS_APOW); const f32x2* BBAR = (const f32x2*)(ws + WS_BBAR); const float* KTAB = (const float*)(ws + WS_KTAB);
    bf16* BT = (bf16*)(ws + WS_BT); bf16* B1S = (bf16*)(ws + WS_B1S);
    for (int idx = gt; idx < 32 * 512 * 96; idx += NT) {
        const int kp = idx % 96, n = (idx / 96) & 511, g = idx / (96 * 512), t = n >> 4, c = n & 15;
        float v[8];
        if (kp < 64) {
            const int s = kp >> 1, c0 = (kp & 1) * 8;
            if (s != t) { const int dir = s < t ? 0 : 1, k = s < t ? t - s : s - t; const f32x4* kt = (const f32x4*)(KTAB + ((size_t)((g * 2 + dir) * 32 + k) * 256 + c * 16 + c0)); const f32x4 x0 = kt[0], x1 = kt[1];
                v[0] = x0[0]; v[1] = x0[1]; v[2] = x0[2]; v[3] = x0[3]; v[4] = x1[0]; v[5] = x1[1]; v[6] = x1[2]; v[7] = x1[3]; }
            else { const f32x4* k0 = (const f32x4*)(KTAB + ((size_t)((g * 2 + 0) * 32) * 256 + c * 16 + c0)); const f32x4* k1 = (const f32x4*)(KTAB + ((size_t)((g * 2 + 1) * 32) * 256 + c * 16 + c0));
                const f32x4 x0 = k0[0] + k1[0], x1 = k0[1] + k1[1]; const float dv = a.in[17][g * 16 + c];
                v[0] = x0[0]; v[1] = x0[1]; v[2] = x0[2]; v[3] = x0[3]; v[4] = x1[0]; v[5] = x1[1]; v[6] = x1[2]; v[7] = x1[3];
#pragma unroll
                for (int i = 0; i < 8; ++i) v[i] += (c == c0 + i) ? dv : 0.f; }
        } else {
            const int j = kp - 64, dir = j >> 4, i8 = (j & 15) * 8, im = i8 >> 6, p0 = i8 & 63, e = dir == 0 ? t + 1 : 32 - t, dg = dir * 32 + g;
            const f32x2* ap = APOW + ((size_t)dg * 33 + e) * 64 + p0; const float* cre = a.in[15] + ((size_t)dg * 16 + c) * 64 + p0; const float* cim = a.in[16] + ((size_t)dg * 16 + c) * 64 + p0;
#pragma unroll
            for (int i = 0; i < 8; ++i) { const f32x2 av = ap[i]; const float cr = cre[i], ci = cim[i]; v[i] = im ? -(cr * av.y + ci * av.x) : (cr * av.x - ci * av.y); }
        }
        v4u o; o.x = cvt_pk_bf16(v[0], v[1]); o.y = cvt_pk_bf16(v[2], v[3]); o.z = cvt_pk_bf16(v[4], v[5]); o.w = cvt_pk_bf16(v[6], v[7]);
        *(v4u*)(BT + ((size_t)(g * 512 + n) * 768 + kp * 8)) = o;
    }
    for (int idx = gt; idx < 32 * 256 * 64; idx += NT) {
        const int kp = idx & 63, n = (idx >> 6) & 255, g = idx >> 14, s = kp >> 1, c0 = (kp & 1) * 8, dir = n >> 7, im = (n >> 6) & 1, p = n & 63, e = dir == 0 ? 31 - s : s, dg = dir * 32 + g;
        const f32x2 av = APOW[((size_t)dg * 33 + e) * 64 + p]; const f32x2* bb = BBAR + ((size_t)dg * 64 + p) * 16 + c0;
        float v[8];
#pragma unroll
        for (int i = 0; i < 8; ++i) { const f32x2 b = bb[i]; v[i] = im ? (av.x * b.y + av.y * b.x) : (av.x * b.x - av.y * b.y); }
        v4u o; o.x = cvt_pk_bf16(v[0], v[1]); o.y = cvt_pk_bf16(v[2], v[3]); o.z = cvt_pk_bf16(v[4], v[5]); o.w = cvt_pk_bf16(v[6], v[7]);
        *(v4u*)(B1S + ((size_t)(g * 256 + n) * 512 + kp * 8)) = o;
    }
}
__device__ __forceinline__ void s5_scan(unsigned char* ws, int gt) {
    gt = opq(gt);
    if (gt >= 16 * 32 * 2 * 64) return;
    const int p = gt & 63, dir = (gt >> 6) & 1, g = (gt >> 7) & 31, seq = gt >> 12;
    const int ch0 = seq < 8 ? seq * 128 : 1024 + (seq - 8) * 64, nch = seq < 8 ? 128 : 64;
    const f32x2 a32 = ((const f32x2*)(ws + WS_APOW))[((size_t)(dir * 32 + g) * 33 + 32) * 64 + p];
    const float* S = (const float*)(ws + WS_SST) + (size_t)g * 1536 * 256 + dir * 128 + p; bf16* AP = (bf16*)(ws + WS_AP) + (size_t)g * 1536 * 768 + 512 + dir * 128 + p;
    float hr = 0.f, hi = 0.f;
#pragma unroll 8
    for (int i = 0; i < nch; ++i) {
        const int ch = ch0 + (dir == 0 ? i : nch - 1 - i);
        const float sr = S[(size_t)ch * 256], si = S[(size_t)ch * 256 + 64];
        AP[(size_t)ch * 768] = f2bf(hr); AP[(size_t)ch * 768 + 64] = f2bf(hi);
        const float nr = a32.x * hr - a32.y * hi + sr, ni = a32.x * hi + a32.y * hr + si; hr = nr; hi = ni;
    }
}
__device__ __forceinline__ void sgu_phase(LAS unsigned char* lds, const Args& a, unsigned char* ws, int ubeg, int uend, int rel, int nrel, int tid) {
    if (rel < 0) return;
    const int tid0 = tid;
    const bf16* ZUB = (const bf16*)(ws + WS_ZUB); const bf16* ZVB = (const bf16*)(ws + WS_ZVB); const float* LNP = (const float*)(ws + WS_LNP); const bf16* WSB = (const bf16*)(ws + WS_WSB); bf16* CAT = (bf16*)a.out;
    const float* ng = a.in[19]; const float* nb = a.in[20]; const float* bs = a.in[22];
    LAS bf16* VTl = (LAS bf16*)lds;
    for (int unit = ubeg + rel; unit < uend; unit += nrel) {
        const int tid = opq(tid0), lane = tid & 63, wave = tid >> 6, fr = lane & 15, fq = lane >> 4;
        const int ck = unit >> 2, h = unit & 3, tok0 = ck * 128, j = tid >> 2;
        float s1 = 0.f, s2 = 0.f;
        { const f32x4* lp = (const f32x4*)(LNP + (size_t)(tok0 + j) * 16);
#pragma unroll
          for (int q = 0; q < 4; ++q) { const f32x4 v = lp[q]; s1 += v[0] + v[2]; s2 += v[1] + v[3]; } }
        const float mean = s1 * (1.0f / 512.0f), var = s2 * (1.0f / 512.0f) - mean * mean, rstd = __builtin_amdgcn_rsqf(var + 1e-6f);
#pragma unroll
        for (int it = 0; it < 4; ++it) {
            const int d0 = ((tid & 3) + 4 * it) * 8;
            const v4u raw = *(const v4u*)(ZVB + (size_t)(tok0 + j) * 512 + h * 128 + d0);
            const f32x4 g0 = *(const f32x4*)(ng + h * 128 + d0), g1 = *(const f32x4*)(ng + h * 128 + d0 + 4), b0 = *(const f32x4*)(nb + h * 128 + d0), b1 = *(const f32x4*)(nb + h * 128 + d0 + 4);
            float x[8] = {bf_lo(raw.x), bf_hi(raw.x), bf_lo(raw.y), bf_hi(raw.y), bf_lo(raw.z), bf_hi(raw.z), bf_lo(raw.w), bf_hi(raw.w)};
#pragma unroll
            for (int e = 0; e < 8; ++e) { const float gg = e < 4 ? g0[e & 3] : g1[e & 3], bb = e < 4 ? b0[e & 3] : b1[e & 3]; VTl[(d0 + e) * 136 + j] = f2bf((x[e] - mean) * rstd * gg + bb); }
        }
        __syncthreads();
        bf16x8 wsf[4];
#pragma unroll
        for (int kk = 0; kk < 4; ++kk) wsf[kk] = *(const bf16x8*)(WSB + (size_t)(h * 128 + wave * 16 + fr) * 128 + 32 * kk + 8 * fq);
        f32x4 acc[8];
#pragma unroll
        for (int dt = 0; dt < 8; ++dt) acc[dt] = (f32x4){0.f, 0.f, 0.f, 0.f};
#pragma unroll
        for (int kk = 0; kk < 4; ++kk)
#pragma unroll
            for (int dt = 0; dt < 8; ++dt) { const bf16x8 vf = *(const LAS bf16x8*)(VTl + (16 * dt + fr) * 136 + 32 * kk + 8 * fq); acc[dt] = __builtin_amdgcn_mfma_f32_16x16x32_bf16(vf, wsf[kk], acc[dt], 0, 0, 0); }
        const int token = tok0 + wave * 16 + fr; const float bias = bs[h * 128 + wave * 16 + fr];
#pragma unroll
        for (int dt = 0; dt < 8; ++dt) { const int d = 16 * dt + 4 * fq; const v2u ub = *(const v2u*)(ZUB + (size_t)token * 512 + h * 128 + d);
            v2u o; o.x = cvt_pk_bf16(bf_lo(ub.x) * (acc[dt][0] + bias), bf_hi(ub.x) * (acc[dt][1] + bias)); o.y = cvt_pk_bf16(bf_lo(ub.y) * (acc[dt][2] + bias), bf_hi(ub.y) * (acc[dt][3] + bias));
            *(v2u*)(CAT + (size_t)token * 1024 + 512 + h * 128 + d) = o; }
        __syncthreads();
    }
}
__device__ __forceinline__ void pool_phase(LAS unsigned char* lds, const bf16* XB, const float* part, bf16* P, int G, int bx, int tid0) {
    LAS float* tile = (LAS float*)lds;
    LAS float* rsl = (LAS float*)(lds + 98304);
    const int vcu = (G % 8 == 0) ? (bx % 8) * (G / 8) + bx / 8 : bx;
    for (int unit = vcu; unit < 3072; unit += G) {
        const int tid = opq(tid0);
        const int t0 = (unit >> 1) * 32, hf = unit & 1; const int seq0 = t0 < 32768 ? (t0 & ~4095) : (t0 & ~2047), L = t0 < 32768 ? 4096 : 2048;
        __syncthreads();
        if (tid < 48) { int r = t0 - 8 + tid; r = r < 0 ? 0 : (r > M - 1 ? M - 1 : r); const f32x4* pp = (const f32x4*)(part + (size_t)r * 16); const f32x4 s4 = (pp[0] + pp[1]) + (pp[2] + pp[3]); rsl[tid] = rsq_eps((s4[0] + s4[1]) + (s4[2] + s4[3])); }
        v2u v[12];
#pragma unroll
        for (int i = 0; i < 12; ++i) { const int idx = tid + 512 * i, row = idx >> 7, q = idx & 127; int r = t0 - 8 + row; r = r < 0 ? 0 : (r > M - 1 ? M - 1 : r); v[i] = __builtin_nontemporal_load((const v2u*)(XB + (size_t)r * 1024 + hf * 512 + q * 4)); }
        __syncthreads();
#pragma unroll
        for (int i = 0; i < 12; ++i) { const int idx = tid + 512 * i, row = idx >> 7, q = idx & 127; *(LAS f32x4*)(tile + row * 512 + q * 4) = (f32x4){bf_lo(v[i].x), bf_hi(v[i].x), bf_lo(v[i].y), bf_hi(v[i].y)} * rsl[row]; }
        __syncthreads();
        const int q = tid & 127, rg = tid >> 7, ch0 = hf * 512 + q * 4, gi = ch0 >> 8, hw = 1 << gi;
        int pos = t0 + rg * 8 - seq0; const int lr0 = 8 - (t0 - seq0);
#define TL(p_) (*(const LAS f32x4*)(tile + ((p_) + lr0) * 512 + q * 4))
        f32x4 s = (f32x4){0.f, 0.f, 0.f, 0.f};
        { const int lo = pos - hw < 0 ? 0 : pos - hw, hi = pos + hw > L ? L : pos + hw; for (int j2 = lo; j2 < hi; ++j2) s += TL(j2); }
#pragma unroll
        for (int i = 0; i < 8; ++i, ++pos) {
            const int lo = pos - hw < 0 ? 0 : pos - hw, hi = pos + hw > L ? L : pos + hw;
            const f32x4 o = s * (1.0f / (float)(hi - lo)) - TL(pos);
            v2u w; w.x = cvt_pk_bf16(o[0], o[1]); w.y = cvt_pk_bf16(o[2], o[3]); *(v2u*)(P + (size_t)(seq0 + pos) * 1024 + ch0) = w;
            if (i < 7) { if (pos + hw < L) s += TL(pos + hw); if (pos - hw >= 0) s -= TL(pos - hw); }
        }
#undef TL
    }
}
__device__ __forceinline__ void attn_phase(LAS unsigned char* lds, const bf16* QO, bf16* OB, const bf16* KB, const bf16* VT, int G, int bx, int tid) {
    constexpr int BUF = 69632;
    const int tid0 = tid;
    const int vcu = (G % 8 == 0) ? (bx % 8) * (G / 8) + bx / 8 : bx;
    for (int unit = vcu; unit < 768; unit += G) {
        const int tid = opq(tid0), lane = tid & 63, wave = tid >> 6, fr = lane & 15, fq = lane >> 4;
        int b16, h, row0;
        if (unit < 512) { b16 = unit >> 6; h = (unit >> 4) & 3; row0 = b16 * 4096 + (unit & 15) * 256; }
        else { const int u2 = unit - 512; b16 = 8 + (u2 >> 5); h = (u2 >> 3) & 3; row0 = 32768 + (b16 - 8) * 2048 + (u2 & 7) * 256; }
        const size_t qoff = (size_t)(row0 + wave * 32 + fr) * 1024 + h * 256;
        bf16x8 qf[2][8];
#pragma unroll
        for (int t = 0; t < 2; ++t)
#pragma unroll
            for (int kk = 0; kk < 8; ++kk) qf[t][kk] = *(const bf16x8*)(QO + qoff + (size_t)t * 16 * 1024 + 32 * kk + 8 * fq);
        const bf16* kbase = KB + (size_t)(b16 * 256) * 1024 + h * 256;
#pragma unroll
        for (int hh = 0; hh < 2; ++hh) {
            v4u tmp[8];
#pragma unroll
            for (int it = 0; it < 8; ++it) tmp[it] = *(const v4u*)(kbase + (size_t)(hh * 128 + (tid >> 5) + 16 * it) * 1024 + (tid & 31) * 8);
#pragma unroll
            for (int it = 0; it < 8; ++it) *(LAS v4u*)(lds + hh * BUF + ((tid >> 5) + 16 * it) * 528 + (tid & 31) * 16) = tmp[it];
        }
        __syncthreads();
        f32x4 sacc[2][16];
#pragma unroll
        for (int n = 0; n < 16; ++n) { sacc[0][n] = (f32x4){0.f, 0.f, 0.f, 0.f}; sacc[1][n] = (f32x4){0.f, 0.f, 0.f, 0.f}; }
        {
#define KRD(i_) (*(const LAS bf16x8*)(lds + ((i_) >> 6) * BUF + ((((i_) >> 3) & 7) * 16 + fr) * 528 + (32 * ((i_) & 7) + 8 * fq) * 2))
            bf16x8 kfb[4];
#pragma unroll
            for (int i = 0; i < 4; ++i) kfb[i] = KRD(i);
#pragma unroll
            for (int i = 0; i < 128; ++i) { const bf16x8 c = kfb[i & 3]; if (i + 4 < 128) kfb[i & 3] = KRD(i + 4);
                sacc[0][i >> 3] = __builtin_amdgcn_mfma_f32_16x16x32_bf16(c, qf[0][i & 7], sacc[0][i >> 3], 0, 0, 0); sacc[1][i >> 3] = __builtin_amdgcn_mfma_f32_16x16x32_bf16(c, qf[1][i & 7], sacc[1][i >> 3], 0, 0, 0); }
#undef KRD
        }
        __syncthreads();
        const bf16* vbase = VT + (size_t)(h * 256) * 4096 + b16 * 256;
#pragma unroll
        for (int hh = 0; hh < 2; ++hh) {
            v4u tmp[8];
#pragma unroll
            for (int it = 0; it < 8; ++it) tmp[it] = *(const v4u*)(vbase + (size_t)((tid >> 4) + 32 * it) * 4096 + hh * 128 + (tid & 15) * 8);
#pragma unroll
            for (int it = 0; it < 8; ++it) *(LAS v4u*)(lds + hh * BUF + ((tid >> 4) + 32 * it) * 272 + (tid & 15) * 16) = tmp[it];
        }
        bf16x8 pf[2][8]; float inv[2];
#pragma unroll
        for (int t = 0; t < 2; ++t) {
            float mx = -3.0e38f;
#pragma unroll
            for (int n = 0; n < 16; ++n) mx = fmaxf(fmaxf(mx, fmaxf(sacc[t][n][0], sacc[t][n][1])), fmaxf(sacc[t][n][2], sacc[t][n][3]));
            mx = fmaxf(mx, __shfl_xor(mx, 16)); mx = fmaxf(mx, __shfl_xor(mx, 32));
            float lsum = 0.f;
#pragma unroll
            for (int n = 0; n < 16; ++n) {
#pragma unroll
                for (int e = 0; e < 4; ++e) { const float pv = __builtin_amdgcn_exp2f(sacc[t][n][e] - mx); sacc[t][n][e] = pv; lsum += pv; } }
            lsum += __shfl_xor(lsum, 16); lsum += __shfl_xor(lsum, 32);
            inv[t] = __builtin_amdgcn_rcpf(lsum);
#pragma unroll
            for (int kk = 0; kk < 8; ++kk) { v4u w; w.x = cvt_pk_bf16(sacc[t][2 * kk][0], sacc[t][2 * kk][1]); w.y = cvt_pk_bf16(sacc[t][2 * kk][2], sacc[t][2 * kk][3]); w.z = cvt_pk_bf16(sacc[t][2 * kk + 1][0], sacc[t][2 * kk + 1][1]); w.w = cvt_pk_bf16(sacc[t][2 * kk + 1][2], sacc[t][2 * kk + 1][3]); pf[t][kk] = __builtin_bit_cast(bf16x8, w); }
        }
        __syncthreads();
        {
#define VRD(i_, off_) (*(const LAS v2u*)(lds + (((i_) & 7) >> 2) * BUF + (16 * ((i_) >> 3) + fr) * 272 + ((((i_) & 7) & 3) * 32 + 4 * fq) * 2 + (off_)))
            v2u vlo[4], vhi[4];
#pragma unroll
            for (int i = 0; i < 4; ++i) { vlo[i] = VRD(i, 0); vhi[i] = VRD(i, 32); }
            f32x4 o0 = (f32x4){0.f, 0.f, 0.f, 0.f}, o1 = (f32x4){0.f, 0.f, 0.f, 0.f};
#pragma unroll
            for (int i = 0; i < 128; ++i) {
                v4u w; w.x = vlo[i & 3].x; w.y = vlo[i & 3].y; w.z = vhi[i & 3].x; w.w = vhi[i & 3].y; const bf16x8 vf = __builtin_bit_cast(bf16x8, w);
                if (i + 4 < 128) { vlo[i & 3] = VRD(i + 4, 0); vhi[i & 3] = VRD(i + 4, 32); }
                o0 = __builtin_amdgcn_mfma_f32_16x16x32_bf16(vf, pf[0][i & 7], o0, 0, 0, 0); o1 = __builtin_amdgcn_mfma_f32_16x16x32_bf16(vf, pf[1][i & 7], o1, 0, 0, 0);
                if ((i & 7) == 7) { const int dt = i >> 3;
                    v2u ow; ow.x = cvt_pk_bf16(o0[0] * inv[0], o0[1] * inv[0]); ow.y = cvt_pk_bf16(o0[2] * inv[0], o0[3] * inv[0]);
                    *(v2u*)(OB + qoff + 16 * dt + 4 * fq) = ow;
                    ow.x = cvt_pk_bf16(o1[0] * inv[1], o1[1] * inv[1]); ow.y = cvt_pk_bf16(o1[2] * inv[1], o1[3] * inv[1]);
                    *(v2u*)(OB + qoff + (size_t)16 * 1024 + 16 * dt + 4 * fq) = ow;
                    o0 = (f32x4){0.f, 0.f, 0.f, 0.f}; o1 = (f32x4){0.f, 0.f, 0.f, 0.f}; }
            }
#undef VRD
        }
        __syncthreads();
    }
}

#define XB_TMO      128
#define XB_XCNT(j)  (256  + 64 * (j))
#define XB_XSUB(j)  (1280 + 64 * (j))
#define XB_XGEN(j)  (2304 + 64 * (j))
#define XB_TOP      3328
#define XB_TOPGEN   3392
#define XCD_BAR_WORDS 3456
#define XB_SPIN_CAP (1u << 18)

__device__ __forceinline__ unsigned xb_ld(unsigned* p)              { return __hip_atomic_load(p, __ATOMIC_RELAXED, __HIP_MEMORY_SCOPE_AGENT); }
__device__ __forceinline__ unsigned xb_add(unsigned* p, unsigned v) { return __hip_atomic_fetch_add(p, v, __ATOMIC_RELAXED, __HIP_MEMORY_SCOPE_AGENT); }
__device__ __forceinline__ unsigned xb_xcc_id() { return (unsigned)__builtin_amdgcn_s_getreg((3 << 11) | 20) & 0xFu; }
#define XB_SPIN(cond, bar) do { unsigned _sp = 0; while (cond) { __builtin_amdgcn_s_sleep(1); \
    if ((++_sp & 255u) == 0u) { if (xb_ld(&(bar)[XB_TMO])) break; if (_sp > XB_SPIN_CAP) { atomicAdd(&(bar)[XB_TMO], 1u); break; } } } } while (0)

struct XcdBarrier {
    unsigned* bar; unsigned x;
    volatile LAS unsigned* st;
};

__device__ __forceinline__ XcdBarrier xcd_barrier_post(unsigned* bar, volatile LAS unsigned* st) {
    XcdBarrier b; b.bar = bar; b.x = xb_xcc_id(); b.st = st;
    if (threadIdx.x == 0) (void)xb_add(&bar[XB_XCNT(b.x)], 1u);
    return b;
}
__device__ __forceinline__ void xcd_barrier_complete(unsigned* bar, unsigned x, unsigned& nloc, unsigned& nx) {
    const unsigned G = gridDim.x * gridDim.y * gridDim.z;
    unsigned sum, cnt, mine, sp = 0u;
    for (;;) {
        sum = 0u; cnt = 0u; mine = 0u;
#pragma unroll
        for (unsigned j = 0; j < 16; ++j) { const unsigned c = xb_ld(&bar[XB_XCNT(j)]); sum += c; cnt += (c > 0u) ? 1u : 0u; mine = (j == x) ? c : mine; }
        if (sum == G) break;
        __builtin_amdgcn_s_sleep(1);
        if ((++sp & 255u) == 0u) { if (xb_ld(&bar[XB_TMO])) break; if (sp > XB_SPIN_CAP) { atomicAdd(&bar[XB_TMO], 1u); break; } }
    }
    nloc = mine > 0u ? mine : 1u; nx = cnt > 0u ? cnt : 1u;
}

__device__ __forceinline__ void xcd_barrier(const XcdBarrier& b) {
    asm volatile("s_waitcnt vmcnt(0)" ::: "memory");
    __syncthreads();
    if (threadIdx.x == 0) {
        unsigned* bar = b.bar;
        __builtin_amdgcn_s_waitcnt(0);
        unsigned nloc = b.st[0], nx = b.st[1];
        if (nloc == 0u) { xcd_barrier_complete(bar, b.x, nloc, nx); b.st[0] = nloc; b.st[1] = nx; }
        const unsigned old = xb_add(&bar[XB_XSUB(b.x)], 1u);
        const unsigned gen = old / nloc;
        if (old + 1u == (gen + 1u) * nloc) {
            __builtin_amdgcn_fence(__ATOMIC_RELEASE, "agent");
            asm volatile("s_waitcnt vmcnt(0)" ::: "memory");
            const unsigned og = xb_add(&bar[XB_TOP], 1u);
            const unsigned tg = og / nx;
            if (og + 1u == (tg + 1u) * nx) xb_add(&bar[XB_TOPGEN], 1u);
            else XB_SPIN(xb_ld(&bar[XB_TOPGEN]) == tg, bar);
            __builtin_amdgcn_fence(__ATOMIC_ACQUIRE, "agent");
            xb_add(&bar[XB_XGEN(b.x)], 1u);
            asm volatile("s_waitcnt vmcnt(0)" ::: "memory");
        } else {
            XB_SPIN(xb_ld(&bar[XB_XGEN(b.x)]) == gen, bar);
            __builtin_amdgcn_fence(__ATOMIC_ACQUIRE, "agent");
            asm volatile("s_waitcnt vmcnt(0)" ::: "memory");
        }
    }
    __syncthreads();
}

__device__ __forceinline__ void final_phase(float* OUT, const bf16* XB, const float* part, const float* gain, int gw, int NGW, int lane) {
    gw = opq(gw); lane = opq(lane);
    f32x4 g[4];
#pragma unroll
    for (int j = 0; j < 4; ++j) g[j] = ((const f32x4*)gain)[lane + 64 * j];
    for (int r0 = gw; r0 < M; r0 += 4 * NGW) {
        v2u w[4][4]; float s[4];
#pragma unroll
        for (int q = 0; q < 4; ++q) { const int r = r0 + q * NGW < M ? r0 + q * NGW : r0; s[q] = lane < 16 ? part[(size_t)r * 16 + lane] : 0.f;
#pragma unroll
            for (int j = 0; j < 4; ++j) w[q][j] = __builtin_nontemporal_load((const v2u*)(XB + (size_t)r * D) + lane + 64 * j); }
#pragma unroll
        for (int q = 0; q < 4; ++q) { const int r = r0 + q * NGW < M ? r0 + q * NGW : r0; const float rs = rsq_eps(wave_sum(s[q]));
#pragma unroll
            for (int j = 0; j < 4; ++j) { const f32x4 v = (f32x4){bf_lo(w[q][j].x), bf_hi(w[q][j].x), bf_lo(w[q][j].y), bf_hi(w[q][j].y)} * g[j] * rs; __builtin_nontemporal_store(v, (f32x4*)(OUT + (size_t)r * D) + lane + 64 * j); } }
    }
}

#define XBAR() do { xcd_barrier(bar); if (REP_BAR) xcd_barrier(bar); } while (0)
#ifndef REP_A
#define REP_A 0
#endif
#ifndef REP_Q
#define REP_Q 0
#endif
#ifndef REP_KV
#define REP_KV 0
#endif
#ifndef REP_SCAN
#define REP_SCAN 0
#endif
#ifndef REP_SGU
#define REP_SGU 0
#endif
#ifndef REP_WIN
#define REP_WIN 0
#endif
#ifndef REP_TAB
#define REP_TAB 0
#endif
#ifndef REP_BAR
#define REP_BAR 0
#endif
#ifndef REP_PREP
#define REP_PREP 0
#endif
#ifndef REP_S5
#define REP_S5 0
#endif
#ifndef REP_ATT
#define REP_ATT 0
#endif
#ifndef REP_RES
#define REP_RES 0
#endif
#define REPEAT(flag_, ...) do { __VA_ARGS__ if (flag_) { __VA_ARGS__ } } while (0)
#ifndef REP_GU
#define REP_GU 0
#endif
#ifndef REP_DOWN
#define REP_DOWN 0
#endif
#define GEMM(EPI, g_, nM_, nN_, nG_, c_, E_) do { pg8::Order S_; S_.init(nM_, nN_, nG_, G, c_); pg8::gemm_phase<EPI, pg8::Order, true, true>(lds, g_, S_, E_); } while (0)
#define GEMM_NA(EPI, g_, nM_, nN_, nG_, c_, E_) do { pg8::Order S_; S_.init(nM_, nN_, nG_, G, c_); pg8::gemm_phase<EPI, pg8::Order, false, true>(lds, g_, S_, E_); } while (0)

__global__ void __launch_bounds__(512, 2) mk_fwd(Args a) {
    extern __shared__ __attribute__((aligned(16))) unsigned char lds_raw[];
    LAS unsigned char* lds = (LAS unsigned char*)lds_raw;
    cg::grid_group grid = cg::this_grid();
    const int tid = threadIdx.x, lane = tid & 63, wave = __builtin_amdgcn_readfirstlane(tid >> 6);
    const int G = gridDim.x, bx = blockIdx.x;
    const int gw = bx * 8 + wave, NGW = G * 8, gt = bx * 512 + tid, NT = G * 512;
    unsigned char* ws = a.ws;
    float* X = a.out;
    bf16* XB = (bf16*)(ws + WS_XB); bf16* H = (bf16*)(ws + WS_H); bf16* QO = (bf16*)(ws + WS_QO); bf16* MEMB = (bf16*)(ws + WS_MEMB); bf16* KB = (bf16*)(ws + WS_KB); bf16* VT = (bf16*)(ws + WS_VT);
    bf16* WKV = (bf16*)(ws + WS_WKV);
#define SSQ(i) ((float*)(ws + ((i) ? WS_SSQ1 : WS_SSQ0)))
    constexpr size_t T1K = (size_t)256 * 1024 * 2;

    volatile LAS unsigned* bst = (volatile LAS unsigned*)(lds + 147392);
    if (tid < 2) bst[tid] = 0u;
    if (bx == 0) for (int i = tid; i < XCD_BAR_WORDS; i += 512) ((unsigned*)ws)[i] = 0u;
    __syncthreads();
    REPEAT(REP_PREP, prep_weights(a, ws, lds, 0, bx, G, tid, 0); prep_misc(a, ws, gw, NGW, gt, NT, lane); __syncthreads(););
    grid.sync();
    XcdBarrier bar = xcd_barrier_post((unsigned*)ws, bst);

    int cur = 0;
#pragma unroll 1
    for (int l = 0; l < 2; ++l) {
#pragma unroll 1
        for (int f = 0; f < 2; ++f) {
            const bf16* WGU = (const bf16*)(ws + (f ? WS_WGU2 : WS_WGU1)); const bf16* WD = (const bf16*)(ws + (f ? WS_WD2 : WS_WD1));
            { pg8::Gemm g{XB, WGU, 1024, 1024, 1024, T1K, 0, 0, T1K, 0, nullptr, 1 << 30}; pg8::EpiSwiGLU E{H, (bf16*)X, SSQ(cur)};
              GEMM(pg8::EpiSwiGLU, g, 192, 32, 1, bx, E);
#if REP_GU
              GEMM(pg8::EpiSwiGLU, g, 192, 32, 1, bx, E);
#endif
            }
            if (f == 0 && l == 1) REPEAT(REP_KV,
                { pg8::Gemm g{MEMB, WKV, 1024, 1024, 1024, T1K, 0, 0, T1K, 0, nullptr, 1 << 30}; pg8::EpiRowScale E{KB, 1024, (const float*)(ws + WS_SSQM)}; GEMM(pg8::EpiRowScale, g, 16, 4, 1, (bx + 64) % G, E); }
                { pg8::Gemm g{WKV + (size_t)1024 * 1024, MEMB, 1024, 1024, 1024, T1K, 0, 0, T1K, 0, nullptr, 1 << 30}; pg8::EpiVT E{VT, (const float*)(ws + WS_RSM)}; GEMM(pg8::EpiVT, g, 4, 16, 1, (bx + 128) % G, E); });
            if (f == 0 && l == 0) REPEAT(REP_TAB, s5_tab2(a, ws, gt, NT););
            if (l == 0 && f == 1) prep_weights(a, ws, lds, 1, bx, G, tid, 1);
            if (l == 1 && f == 0 && bx < G / 2) prep_weights(a, ws, lds, 1, bx, G / 2, tid, 3);
            XBAR();
            { pg8::Gemm g{H, WD, 4096, 4096, 4096, T1K * 4, 0, 0, T1K * 4, 0, (const bf16*)X, 128}; pg8::EpiRes E{XB, SSQ(cur ^ 1), 0.5f};
              GEMM(pg8::EpiRes, g, 192, 4, 1, bx, E);
#if REP_DOWN
              { pg8::EpiRes E2 = E; E2.alpha = 0.f; GEMM(pg8::EpiRes, g, 192, 4, 1, bx, E2); }
#endif
            }
            if (f == 0 && l == 0) REPEAT(REP_TAB, s5_tab3(a, ws, gt, NT););
            if (l == 0 && f == 1) prep_weights(a, ws, lds, 1, bx, G, tid, 2);
            XBAR();
            cur ^= 1;
            if (f == 0) {
                pg8::Gemm gm;
                if (l == 0) {
                    REPEAT(REP_WIN, { pg8::Gemm g{XB, (const bf16*)(ws + WS_WIN), 1024, 1024, 1024, T1K, 0, 0, T1K, 0, nullptr, 1 << 30}; pg8::EpiWin E{(bf16*)(ws + WS_AP), (bf16*)(ws + WS_ZUB), (bf16*)(ws + WS_ZVB), (pg8::f32x2*)(ws + WS_LNP), SSQ(cur)}; GEMM(pg8::EpiWin, g, 192, 6, 1, bx, E); });
                    REPEAT(REP_KV,
                        { pg8::Gemm g{MEMB, WKV, 1024, 1024, 1024, T1K, 0, 0, T1K, 0, nullptr, 1 << 30}; pg8::EpiRowScale E{KB, 1024, (const float*)(ws + WS_SSQM)}; GEMM(pg8::EpiRowScale, g, 16, 4, 1, (bx + 64) % G, E); }
                        { pg8::Gemm g{WKV + (size_t)1024 * 1024, MEMB, 1024, 1024, 1024, T1K, 0, 0, T1K, 0, nullptr, 1 << 30}; pg8::EpiVT E{VT, (const float*)(ws + WS_RSM)}; GEMM(pg8::EpiVT, g, 4, 16, 1, (bx + 128) % G, E); });
                    XBAR();
                    REPEAT(REP_S5, { pg8::Gemm g{(const bf16*)(ws + WS_AP), (const bf16*)(ws + WS_B1S), 768, 512, 512, (size_t)256 * 768 * 2, 0, (size_t)1536 * 768 * 2, 0, (size_t)256 * 512 * 2, nullptr, 1 << 30}; pg8::EpiS5aScan E{(float*)(ws + WS_SST), (bf16*)(ws + WS_AP), (const pg8::f32x2*)(ws + WS_APOW)}; GEMM_NA(pg8::EpiS5aScan, g, 6, 1, 32, bx, E); });
                    sgu_phase(lds, a, ws, 0, 640, (bx % 8) * (G / 8) + bx / 8, G, tid);
                    XBAR();
                    REPEAT(REP_S5, { pg8::Gemm g{(const bf16*)(ws + WS_AP), (const bf16*)(ws + WS_BT), 768, 768, 768, (size_t)256 * 768 * 2, 0, (size_t)1536 * 768 * 2, (size_t)256 * 768 * 2, (size_t)512 * 768 * 2, nullptr, 1 << 30}; pg8::EpiS5c E{(bf16*)(ws + WS_GB)}; GEMM(pg8::EpiS5c, g, 6, 2, 32, bx, E); });
                    sgu_phase(lds, a, ws, 640, 1152, bx >= G / 2 ? bx - G / 2 : -1, G / 2, tid);
                    XBAR();
                    REPEAT(REP_S5, { pg8::Gemm g{(const bf16*)(ws + WS_GB), (const bf16*)(ws + WS_WGLU), 512, 512, 512, (size_t)256 * 512 * 2, 0, 0, (size_t)256 * 512 * 2, 0, nullptr, 1 << 30}; pg8::EpiGLU E{(const bf16*)(ws + WS_GB), (bf16*)X}; GEMM(pg8::EpiGLU, g, 192, 2, 1, bx, E); });
                    sgu_phase(lds, a, ws, 1152, 1536, bx >= G / 2 ? bx - G / 2 : -1, G / 2, tid);
                    XBAR();
                    gm = pg8::Gemm{(const bf16*)X, (const bf16*)(ws + WS_WOUT), 1024, 1024, 1024, T1K, 0, 0, T1K, 0, nullptr, 1 << 30};
                } else {
                    REPEAT(REP_RES, pool_phase(lds, XB, SSQ(cur), (bf16*)(ws + WS_POOLED), G, bx, tid););
                    XBAR();
                    gm = pg8::Gemm{(const bf16*)(ws + WS_POOLED), (const bf16*)(ws + WS_WPOOL), 1024, 256, 256, T1K, (size_t)256 * 2, 0, (size_t)256 * 256 * 2, 0, nullptr, 1 << 30};
                }
                { pg8::EpiRes E{XB, SSQ(cur ^ 1), 1.0f}; GEMM(pg8::EpiRes, gm, 192, 4, 1, bx, E); if (REP_RES) { E.alpha = 0.f; GEMM(pg8::EpiRes, gm, 192, 4, 1, bx, E); } }
                XBAR();
                cur ^= 1;
                { pg8::Gemm g{XB, (const bf16*)(ws + WS_WQ), 1024, 1024, 1024, T1K, 0, 0, T1K, 0, nullptr, 1 << 30}; pg8::EpiRowScale E{QO, 1024, SSQ(cur)}; REPEAT(REP_Q, GEMM(pg8::EpiRowScale, g, 192, 4, 1, bx, E);); }
                XBAR();
                REPEAT(REP_A, attn_phase(lds, QO, (bf16*)(ws + WS_CAT), KB, VT, G, bx, tid););
                XBAR();
                { pg8::Gemm g{(const bf16*)(ws + WS_CAT), (const bf16*)(ws + WS_WO), 1024, 1024, 1024, T1K, 0, 0, T1K, 0, nullptr, 1 << 30}; pg8::EpiRes E{XB, SSQ(cur ^ 1), 1.0f}; GEMM(pg8::EpiRes, g, 192, 4, 1, bx, E); if (REP_RES) { E.alpha = 0.f; GEMM(pg8::EpiRes, g, 192, 4, 1, bx, E); } }
                XBAR();
                cur ^= 1;
            }
        }
    }
    final_phase(X, XB, SSQ(cur), a.in[35], gw, NGW, lane);
#ifdef REP_FINAL
    final_phase(X, XB, SSQ(cur), a.in[35], gw, NGW, lane);
#endif
}

extern "C" void kernel_launch(void* const* d_in, const int* in_sizes, int n_in, void* d_out, int out_size, void* d_ws, size_t ws_size, hipStream_t stream) {
    static int grid = 0;
    if (grid == 0) {
        if (n_in != 36 || out_size != M * D || ws_size < WS_END) { fprintf(stderr, "kernel_launch: unexpected shapes: n_in %d out %d ws %zu (need %zu)\n", n_in, out_size, ws_size, (size_t)WS_END); grid = -1; return; }
        int dev = 0, cus = 0, per_cu = 0;
        hipGetDevice(&dev);
        hipDeviceGetAttribute(&cus, hipDeviceAttributeMultiprocessorCount, dev);
        hipFuncSetAttribute((const void*)mk_fwd, hipFuncAttributeMaxDynamicSharedMemorySize, LDS_BYTES);
        hipOccupancyMaxActiveBlocksPerMultiprocessor(&per_cu, (const void*)mk_fwd, 512, LDS_BYTES);
        (void)hipGetLastError();
        grid = cus;
        if (grid % 8 != 0 || grid < 8) grid = (grid / 8) * 8;
        fprintf(stderr, "kernel_launch: grid %d (occupancy query: %d per CU), ws %zu\n", grid, per_cu, ws_size);
    }
    if (grid <= 0) return;
    Args a{};
    for (int i = 0; i < 36; ++i) a.in[i] = (const float*)d_in[i];
    a.out = (float*)d_out; a.ws = (unsigned char*)d_ws;
    void* args[] = {&a};
    hipError_t e = hipLaunchCooperativeKernel((const void*)mk_fwd, dim3(grid), dim3(512), args, LDS_BYTES, stream);
    if (e != hipSuccess) fprintf(stderr, "kernel_launch: cooperative launch failed: %s (grid %d)\n", hipGetErrorString(e), grid);
}
```

```cpp
#include <hip/hip_runtime.h>
#include <hip/hip_cooperative_groups.h>
#include <cstdio>
#include <cstdint>
namespace cg = cooperative_groups;

__device__ __forceinline__ int opq(int v) { asm volatile("" : "+v"(v)); return v; }

namespace pg8 {
#define PG8_LAS __attribute__((address_space(3)))
typedef unsigned short bf16_t;
typedef short bf16x8 __attribute__((ext_vector_type(8)));
typedef float f32x4 __attribute__((ext_vector_type(4)));
typedef float f32x2 __attribute__((ext_vector_type(2)));
typedef unsigned u32x4 __attribute__((ext_vector_type(4)));
typedef unsigned u32x2 __attribute__((ext_vector_type(2)));
constexpr int BM = 256, BK = 64, HALF = 128, HTB = HALF * BK * 2  , STAGE_BYTES = 8 * HTB, NXCD = 8, WGM = 8;

__host__ __device__ __forceinline__ int lds_byte(int r, int c) { const int st = (r >> 4) * 2 + (c >> 5), rr = r & 15, cc = c & 31, ob = rr * 64 + cc * 2; return st * 1024 + (ob ^ (((ob >> 9) & 1) << 5)); }
__host__ __device__ __forceinline__ void stage_rc(int b, int& R, int& C) { const int st = b / 1024, sb = b % 1024, swz = sb ^ (((sb >> 9) & 1) << 5); R = (st >> 1) * 16 + swz / 64; C = (st & 1) * 32 + (swz % 64) / 2; }
__host__ __device__ __forceinline__ int perm32(int rho) { const int n = rho >> 4, i = rho & 15; return 8 * (i >> 2) + 4 * n + (i & 3); }

struct Unit { int pm, pn, g; };
struct Gemm { const bf16_t* A; const bf16_t* Bt; int lda, ldb, K; size_t a_pm, a_pn, a_g, b_pn, b_g; const bf16_t* A2; int pm2; };

struct Order {
    int nM, nN, nwg, tot, G, c;
    __device__ __forceinline__ void init(int nM_, int nN_, int nG_, int G_, int c_) { nM = nM_; nN = nN_; nwg = nM_ * nN_; tot = nwg * nG_; G = G_; c = c_; }
    __device__ __forceinline__ bool next(int i, Unit& u) const {
        const int L = i * G + c; if (L >= tot) return false;
        if (tot == nwg) {
            int wgid = L; { const int q = nwg / NXCD, r = nwg % NXCD, xcd = wgid % NXCD, off = wgid / NXCD; wgid = (xcd < r ? xcd * (q + 1) : r * (q + 1) + (xcd - r) * q) + off; }
            const int nig = WGM * nN, gid = wgid / nig, fm = gid * WGM, gsz = (nM - fm) < WGM ? (nM - fm) : WGM;
            u.pm = fm + ((wgid % nig) % gsz); u.pn = (wgid % nig) / gsz; u.g = 0;
        } else { u.g = L / nwg; const int r = L % nwg; u.pm = r / nN; u.pn = r % nN; }
        return true;
    }
    __device__ __forceinline__ void a_ready(const Unit&) const {}
    __device__ __forceinline__ void done(const Unit&) const {}
};

typedef __bf16 bf16x2_t __attribute__((ext_vector_type(2)));
__device__ __forceinline__ unsigned cvt_pk_bf16(float lo, float hi) { const f32x2 v = {lo, hi}; const bf16x2_t b = __builtin_convertvector(v, bf16x2_t); return __builtin_bit_cast(unsigned, b); }
__device__ __forceinline__ u32x4 pack8(const f32x4 a, const f32x4 b) { u32x4 w; w.x = cvt_pk_bf16(a[0], a[1]); w.y = cvt_pk_bf16(a[2], a[3]); w.z = cvt_pk_bf16(b[0], b[1]); w.w = cvt_pk_bf16(b[2], b[3]); return w; }
__device__ __forceinline__ float bf_lo(unsigned w) { return __uint_as_float(w << 16); }
__device__ __forceinline__ float bf_hi(unsigned w) { return __uint_as_float(w & 0xffff0000u); }
__device__ __forceinline__ float sigm(float x) { return __builtin_amdgcn_rcpf(1.0f + __builtin_amdgcn_exp2f(-1.4426950408889634f * x)); }
__device__ __forceinline__ float silu_f(float x) { return x * sigm(x); }
__device__ __forceinline__ float gelu_t(float x) { return x * sigm(1.5957691216057308f * (x + 0.044715f * x * x * x)); }
__device__ __forceinline__ f32x4 gelu4(const f32x4 x) { f32x4 t = (x * x * 0.044715f + 1.0f) * x * (-1.5957691216057308f * 1.4426950408889634f);
    _Pragma("unroll") for (int e = 0; e < 4; ++e) t[e] = __builtin_amdgcn_exp2f(t[e]);
    t += 1.0f;
    _Pragma("unroll") for (int e = 0; e < 4; ++e) t[e] = __builtin_amdgcn_rcpf(t[e]);
    return x * t; }
__device__ __forceinline__ float fq_sum(float v) {
    auto r16 = __builtin_amdgcn_permlane16_swap(__float_as_uint(v), __float_as_uint(v), false, false); v = __uint_as_float(r16[0]) + __uint_as_float(r16[1]);
    auto r32 = __builtin_amdgcn_permlane32_swap(__float_as_uint(v), __float_as_uint(v), false, false); return __uint_as_float(r32[0]) + __uint_as_float(r32[1]); }
__device__ __forceinline__ float row_rs16(const float* part, int row, int fq) {
    const f32x4 v = *(const f32x4*)(part + (size_t)row * 16 + fq * 4);
    float s = (v[0] + v[1]) + (v[2] + v[3]); s += __shfl_xor(s, 16); s += __shfl_xor(s, 32);
    return __builtin_amdgcn_rsqf(s * (1.0f / 1024.0f) + 1e-6f);
}
#define EPI_ROWS(...) _Pragma("unroll") for (int ai = 0; ai < 2; ++ai) _Pragma("unroll") for (int m = 0; m < 4; ++m) { const int row = u.pm * BM + ai * HALF + wr * 64 + m * 16 + fr; __VA_ARGS__ }

#define EPI_RS8(part_) float rsv[2][4]; { f32x4 pq_[2][4]; \
    _Pragma("unroll") for (int ai = 0; ai < 2; ++ai) _Pragma("unroll") for (int m = 0; m < 4; ++m) pq_[ai][m] = *(const f32x4*)((part_) + (size_t)(u.pm * BM + ai * HALF + wr * 64 + m * 16 + fr) * 16 + fq * 4); \
    _Pragma("unroll") for (int ai = 0; ai < 2; ++ai) _Pragma("unroll") for (int m = 0; m < 4; ++m) rsv[ai][m] = (pq_[ai][m][0] + pq_[ai][m][1]) + (pq_[ai][m][2] + pq_[ai][m][3]); \
    _Pragma("unroll") for (int ai = 0; ai < 2; ++ai) _Pragma("unroll") for (int m = 0; m < 4; ++m) rsv[ai][m] = fq_sum(rsv[ai][m]); \
    _Pragma("unroll") for (int ai = 0; ai < 2; ++ai) _Pragma("unroll") for (int m = 0; m < 4; ++m) rsv[ai][m] = __builtin_amdgcn_rsqf(rsv[ai][m] * (1.0f / 1024.0f) + 1e-6f); }
struct EpiSwiGLU {
    static constexpr bool PERM = true, AFTER_DRAIN = false;
    bf16_t* H; bf16_t* H2; const float* part;
    __device__ __forceinline__ void operator()(const f32x4 (&acc)[2][2][4][2], const Unit& u, int wr, int wc, int fr, int fq) const {
        const int col = u.pn * HALF + wc * 32 + fq * 8;
        bf16_t* hb = u.pm < 128 ? H : H2 - (size_t)32768 * 4096;
        EPI_RS8(part)
        EPI_ROWS(
            const float rs = rsv[ai][m];
            const f32x4 g0 = acc[ai][0][m][0] * rs, g1 = acc[ai][0][m][1] * rs, u0 = acc[ai][1][m][0] * rs, u1 = acc[ai][1][m][1] * rs;
            f32x4 e0 = g0 * -1.4426950408889634f, e1 = g1 * -1.4426950408889634f;
            _Pragma("unroll") for (int e = 0; e < 4; ++e) { e0[e] = __builtin_amdgcn_exp2f(e0[e]); e1[e] = __builtin_amdgcn_exp2f(e1[e]); }
            e0 += 1.0f; e1 += 1.0f;
            _Pragma("unroll") for (int e = 0; e < 4; ++e) { e0[e] = __builtin_amdgcn_rcpf(e0[e]); e1[e] = __builtin_amdgcn_rcpf(e1[e]); }
            const f32x4 h0 = (g0 * u0) * e0, h1 = (g1 * u1) * e1;
            __builtin_nontemporal_store(pack8(h0, h1), (u32x4*)(hb + (size_t)row * 4096 + col));
        )
    }
};
struct EpiRes {
    static constexpr bool PERM = true, AFTER_DRAIN = false;
    bf16_t* xb; float* part_out; float alpha;
    __device__ __forceinline__ void operator()(const f32x4 (&acc)[2][2][4][2], const Unit& u, int wr, int wc, int fr, int fq) const {
        const int col0 = u.pn * BM + wc * 32 + fq * 8;
#pragma unroll
        for (int ai = 0; ai < 2; ++ai) {
            u32x4 xv[4][2];
#pragma unroll
            for (int m = 0; m < 4; ++m)
#pragma unroll
                for (int bj = 0; bj < 2; ++bj) xv[m][bj] = *(const u32x4*)(xb + (size_t)(u.pm * BM + ai * HALF + wr * 64 + m * 16 + fr) * 1024 + col0 + bj * HALF);
#pragma unroll
            for (int m = 0; m < 4; ++m) {
                const int row = u.pm * BM + ai * HALF + wr * 64 + m * 16 + fr;
                float ss = 0.f;
#pragma unroll
                for (int bj = 0; bj < 2; ++bj) {
                    const u32x4 w = xv[m][bj];
                    f32x4 v0 = (f32x4){bf_lo(w.x), bf_hi(w.x), bf_lo(w.y), bf_hi(w.y)}; f32x4 v1 = (f32x4){bf_lo(w.z), bf_hi(w.z), bf_lo(w.w), bf_hi(w.w)};
                    v0 += acc[ai][bj][m][0] * alpha; v1 += acc[ai][bj][m][1] * alpha;
                    ss += (v0[0] * v0[0] + v0[1] * v0[1]) + (v0[2] * v0[2] + v0[3] * v0[3]) + (v1[0] * v1[0] + v1[1] * v1[1]) + (v1[2] * v1[2] + v1[3] * v1[3]);
                    *(u32x4*)(xb + (size_t)row * 1024 + col0 + bj * HALF) = pack8(v0, v1);
                }
                ss = fq_sum(ss);
                if (fq == 0) part_out[(size_t)row * 16 + u.pn * 4 + wc] = ss;
            }
            asm volatile("" ::: "memory");
        }
    }
};
struct EpiRowScale {
    static constexpr bool PERM = true, AFTER_DRAIN = false;
    bf16_t* O; int ldc; const float* part;
    __device__ __forceinline__ void operator()(const f32x4 (&acc)[2][2][4][2], const Unit& u, int wr, int wc, int fr, int fq) const {
        const int col0 = u.pn * BM + wc * 32 + fq * 8;
        EPI_RS8(part)
        EPI_ROWS(
            const float rs = rsv[ai][m];
            _Pragma("unroll") for (int bj = 0; bj < 2; ++bj) *(u32x4*)(O + (size_t)row * ldc + col0 + bj * HALF) = pack8(acc[ai][bj][m][0] * rs, acc[ai][bj][m][1] * rs);
        )
    }
};
struct EpiVT {
    static constexpr bool PERM = true, AFTER_DRAIN = false;
    bf16_t* O; const float* rsm;
    __device__ __forceinline__ void operator()(const f32x4 (&acc)[2][2][4][2], const Unit& u, int wr, int wc, int fr, int fq) const {
        const int col0 = u.pn * BM + wc * 32 + fq * 8;
        f32x4 s[2][2];
        _Pragma("unroll") for (int bj = 0; bj < 2; ++bj) { s[bj][0] = *(const f32x4*)(rsm + col0 + bj * HALF); s[bj][1] = *(const f32x4*)(rsm + col0 + bj * HALF + 4); }
        EPI_ROWS(
            _Pragma("unroll") for (int bj = 0; bj < 2; ++bj) *(u32x4*)(O + (size_t)row * 4096 + col0 + bj * HALF) = pack8(acc[ai][bj][m][0] * s[bj][0], acc[ai][bj][m][1] * s[bj][1]);
        )
    }
};
struct EpiWin {
    static constexpr bool PERM = true, AFTER_DRAIN = false;
    bf16_t* AP; bf16_t* ZUB; bf16_t* ZVB; f32x2* lnp; const float* part;
    __device__ __forceinline__ void operator()(const f32x4 (&acc)[2][2][4][2], const Unit& u, int wr, int wc, int fr, int fq) const {
        const int cl = wc * 32 + fq * 8;
        EPI_RS8(part)
        EPI_ROWS(
            const float rs = rsv[ai][m];
            if (u.pn < 2) {
                _Pragma("unroll") for (int bj = 0; bj < 2; ++bj) { const int c = u.pn * BM + bj * HALF + cl; const int g = c >> 4;
                    *(u32x4*)(AP + ((size_t)(g * 1536 + (row >> 5)) * 768 + (row & 31) * 16 + (c & 15))) = pack8(acc[ai][bj][m][0] * rs, acc[ai][bj][m][1] * rs); }
            } else if (u.pn < 4) {
                _Pragma("unroll") for (int bj = 0; bj < 2; ++bj) { const int c = (u.pn - 2) * BM + bj * HALF + cl; f32x4 a = acc[ai][bj][m][0] * rs, b = acc[ai][bj][m][1] * rs;
                    a = gelu4(a); b = gelu4(b);
                    *(u32x4*)(ZUB + (size_t)row * 512 + c) = pack8(a, b); }
            } else {
                float s1 = 0.f, s2 = 0.f;
                _Pragma("unroll") for (int bj = 0; bj < 2; ++bj) { const int c = (u.pn - 4) * BM + bj * HALF + cl; f32x4 a = acc[ai][bj][m][0] * rs, b = acc[ai][bj][m][1] * rs;
                    a = gelu4(a); b = gelu4(b); _Pragma("unroll") for (int e = 0; e < 4; ++e) { s1 += a[e] + b[e]; s2 += a[e] * a[e] + b[e] * b[e]; }
                    *(u32x4*)(ZVB + (size_t)row * 512 + c) = pack8(a, b); }
                s1 = fq_sum(s1); s2 = fq_sum(s2);
                if (fq == 0) lnp[(size_t)row * 8 + (u.pn - 4) * 4 + wc] = (f32x2){s1, s2};
            }
        )
    }
};
struct EpiF32 {
    static constexpr bool PERM = true, AFTER_DRAIN = false;
    float* O; int ldc; int rows_per_g;
    __device__ __forceinline__ void operator()(const f32x4 (&acc)[2][2][4][2], const Unit& u, int wr, int wc, int fr, int fq) const {
        const int col0 = u.pn * BM + wc * 32 + fq * 8;
        EPI_ROWS(
            _Pragma("unroll") for (int bj = 0; bj < 2; ++bj) { float* p = O + ((size_t)u.g * rows_per_g + row) * ldc + col0 + bj * HALF; *(f32x4*)p = acc[ai][bj][m][0]; *(f32x4*)(p + 4) = acc[ai][bj][m][1]; }
        )
    }
};
struct EpiS5aScan {
    static constexpr bool PERM = true, AFTER_DRAIN = true;
    float* SST; bf16_t* AP; const f32x2* APOW;
    __device__ __forceinline__ void fused(f32x4 (&acc)[2][2][4][2], const Unit& u, int wr, int wc, int fr, int fq, PG8_LAS unsigned char* lds, int wid, int lane) const {
        const int col0 = wc * 32 + fq * 8;
        EPI_ROWS(
            _Pragma("unroll") for (int bj = 0; bj < 2; ++bj) { float* p = SST + ((size_t)u.g * 1536 + row) * 256 + col0 + bj * HALF; *(f32x4*)p = acc[ai][bj][m][0]; *(f32x4*)(p + 4) = acc[ai][bj][m][1]; }
        )
        asm volatile("s_waitcnt vmcnt(0)" ::: "memory"); __builtin_amdgcn_s_barrier(); asm volatile("" ::: "memory");
        const int tid = wid * 64 + lane, p = tid & 63, dir = (tid >> 6) & 1, sl = tid >> 7;
        const bool prompt = u.pm < 4; const int nch = prompt ? 128 : 64, ch0 = u.pm * 256 + sl * nch;
        if (prompt && sl >= 2) return;
        const f32x2 a32 = APOW[((size_t)(dir * 32 + u.g) * 33 + 32) * 64 + p];
        const float* S = SST + (size_t)u.g * 1536 * 256 + dir * 128 + p; bf16_t* H = AP + (size_t)u.g * 1536 * 768 + 512 + dir * 128 + p;
        float hr = 0.f, hi = 0.f;
#pragma unroll 8
        for (int i = 0; i < nch; ++i) {
            const int ch = ch0 + (dir == 0 ? i : nch - 1 - i);
            const float sr = S[(size_t)ch * 256], si = S[(size_t)ch * 256 + 64];
            H[(size_t)ch * 768] = (bf16_t)(cvt_pk_bf16(hr, 0.f) & 0xffffu); H[(size_t)ch * 768 + 64] = (bf16_t)(cvt_pk_bf16(hi, 0.f) & 0xffffu);
            const float nr = a32.x * hr - a32.y * hi + sr, ni = a32.x * hi + a32.y * hr + si; hr = nr; hi = ni;
        }
    }
};
struct EpiS5c {
    static constexpr bool PERM = true, AFTER_DRAIN = false;
    bf16_t* G;
    __device__ __forceinline__ void operator()(const f32x4 (&acc)[2][2][4][2], const Unit& u, int wr, int wc, int fr, int fq) const {
        const int col0 = u.pn * BM + wc * 32 + fq * 8;
        EPI_ROWS(
            _Pragma("unroll") for (int bj = 0; bj < 2; ++bj) { const int col = col0 + bj * HALF; const int t = col >> 4, c = col & 15; f32x4 a = acc[ai][bj][m][0], b = acc[ai][bj][m][1];
                a = gelu4(a); b = gelu4(b);
                *(u32x4*)(G + ((size_t)(row * 32 + t) * 512 + u.g * 16 + c)) = pack8(a, b); }
        )
    }
};
struct EpiGLU {
    static constexpr bool PERM = true, AFTER_DRAIN = false;
    const bf16_t* G; bf16_t* CAT;
    __device__ __forceinline__ void operator()(const f32x4 (&acc)[2][2][4][2], const Unit& u, int wr, int wc, int fr, int fq) const {
        const int col0 = u.pn * BM + wc * 32 + fq * 8;
        EPI_ROWS(
            _Pragma("unroll") for (int bj = 0; bj < 2; ++bj) { const int col = col0 + bj * HALF; const u32x4 gv = *(const u32x4*)(G + (size_t)row * 512 + col);
                f32x4 a, b; a[0] = bf_lo(gv.x) * sigm(acc[ai][bj][m][0][0]); a[1] = bf_hi(gv.x) * sigm(acc[ai][bj][m][0][1]); a[2] = bf_lo(gv.y) * sigm(acc[ai][bj][m][0][2]); a[3] = bf_hi(gv.y) * sigm(acc[ai][bj][m][0][3]);
                b[0] = bf_lo(gv.z) * sigm(acc[ai][bj][m][1][0]); b[1] = bf_hi(gv.z) * sigm(acc[ai][bj][m][1][1]); b[2] = bf_lo(gv.w) * sigm(acc[ai][bj][m][1][2]); b[3] = bf_hi(gv.w) * sigm(acc[ai][bj][m][1][3]);
                *(u32x4*)(CAT + (size_t)row * 1024 + col) = pack8(a, b); }
        )
    }
};

template <class Epi, class Sched, bool ALIGN_EPI = false, bool SP2 = false>
__device__ __forceinline__ void gemm_phase(PG8_LAS unsigned char* lds, const Gemm g, const Sched& S, const Epi& E) {
    const int tid = opq((int)threadIdx.x), wid = __builtin_amdgcn_readfirstlane(tid >> 6), lane = tid & 63, wr = wid >> 2, wc = wid & 3, fr = lane & 15, fq = lane >> 4;
    const int K = g.K, nt = K / BK, lda = g.lda, ldb = g.ldb;
    unsigned voffA[2], voffB[2];
#pragma unroll
    for (int i = 0; i < 2; ++i) { int R, C; stage_rc(tid * 16 + i * 8192, R, C); const int Rb = Epi::PERM ? ((R & ~31) + perm32(R & 31)) : R;
        voffA[i] = (unsigned)(R * lda + C) * 2u; voffB[i] = (unsigned)(Rb * ldb + C) * 2u; }
    const size_t kstep = (size_t)(BK * 2);
    const size_t hstepA = (size_t)HALF * lda * 2, hstepB = (size_t)HALF * ldb * 2;
    const unsigned ldsw = (unsigned)wid * 1024u;
    const int aoff = lds_byte(wr * 64 + fr, fq * 8), boff = lds_byte(wc * 32 + fr, fq * 8);
#define PG8_SA(b, h) (((b) * 2 + (h)) * HTB)
#define PG8_SB(b, h) ((4 + (b) * 2 + (h)) * HTB)
#define PG8_STAGE(bufoff, gbase, voff) do { _Pragma("unroll") for (int _i = 0; _i < 2; ++_i) \
        __builtin_amdgcn_global_load_lds((const unsigned*)((const char*)(gbase) + (voff)[_i]), (PG8_LAS unsigned*)(lds + (bufoff) + ldsw + _i * 8192), 16, 0, 0); } while (0)
#define PG8_LDA(dst, b, h) do { _Pragma("unroll") for (int m = 0; m < 4; ++m) _Pragma("unroll") for (int k = 0; k < 2; ++k) dst[m][k] = *(const PG8_LAS bf16x8*)(lds + PG8_SA(b, h) + aoff + m * 2048 + k * 1024); } while (0)
#define PG8_LDB(dst, b, h) do { _Pragma("unroll") for (int n = 0; n < 2; ++n) _Pragma("unroll") for (int k = 0; k < 2; ++k) dst[n][k] = *(const PG8_LAS bf16x8*)(lds + PG8_SB(b, h) + boff + n * 2048 + k * 1024); } while (0)
#define PG8_MMA(ai, bj, At, Bt) do { __builtin_amdgcn_s_setprio(1); _Pragma("unroll") for (int m = 0; m < 4; ++m) _Pragma("unroll") for (int n = 0; n < 2; ++n) _Pragma("unroll") for (int k = 0; k < 2; ++k) \
        acc[ai][bj][m][n] = __builtin_amdgcn_mfma_f32_16x16x32_bf16(Bt[n][k], At[m][k], acc[ai][bj][m][n], 0, 0, 0); __builtin_amdgcn_s_setprio(0); } while (0)
#define PG8_WAIT_V(n) asm volatile("s_waitcnt vmcnt(" #n ")" ::: "memory")
#define PG8_WAIT_L(n) asm volatile("s_waitcnt lgkmcnt(" #n ")" ::: "memory")
#define PG8_BAR __builtin_amdgcn_s_barrier()
#define PG8_SCHED __builtin_amdgcn_sched_barrier(0)
    Unit cur, nxt; int ui = 0;
    if (!S.next(0, cur)) return;
    f32x4 acc[2][2][4][2];
#pragma unroll
    for (int a = 0; a < 2; ++a)
#pragma unroll
        for (int b = 0; b < 2; ++b)
#pragma unroll
            for (int m = 0; m < 4; ++m)
#pragma unroll
                for (int n = 0; n < 2; ++n) acc[a][b][m][n] = (f32x4){0.f, 0.f, 0.f, 0.f};
    bf16x8 At[4][2], B0[2][2], B1[2][2];
    const char* cA = (cur.pm < g.pm2 ? (const char*)g.A + (size_t)cur.pm * g.a_pm : (const char*)g.A2 + (size_t)(cur.pm - g.pm2) * g.a_pm) + (size_t)cur.pn * g.a_pn + (size_t)cur.g * g.a_g; const char* cB = (const char*)g.Bt + (size_t)cur.pn * g.b_pn + (size_t)cur.g * g.b_g;
    S.a_ready(cur);
    if constexpr (SP2) {
        PG8_STAGE(PG8_SB(0, 0), cB, voffB); PG8_STAGE(PG8_SB(0, 1), cB + hstepB, voffB); PG8_STAGE(PG8_SA(0, 0), cA, voffA); PG8_STAGE(PG8_SA(0, 1), cA + hstepA, voffA);
        if (wr == 1) PG8_BAR;
        PG8_WAIT_V(2); PG8_BAR;
        PG8_STAGE(PG8_SB(1, 0), cB + kstep, voffB); PG8_STAGE(PG8_SA(1, 0), cA + kstep, voffA); PG8_STAGE(PG8_SB(1, 1), cB + hstepB + kstep, voffB);
        PG8_WAIT_V(6); PG8_BAR;
    } else {
        PG8_STAGE(PG8_SB(0, 0), cB, voffB); PG8_STAGE(PG8_SA(0, 0), cA, voffA); PG8_STAGE(PG8_SB(0, 1), cB + hstepB, voffB); PG8_STAGE(PG8_SA(0, 1), cA + hstepA, voffA);
        if (wr == 1) PG8_BAR;
        PG8_WAIT_V(4); PG8_BAR;
        PG8_STAGE(PG8_SB(1, 0), cB + kstep, voffB); PG8_STAGE(PG8_SA(1, 0), cA + kstep, voffA); PG8_STAGE(PG8_SB(1, 1), cB + hstepB + kstep, voffB);
        PG8_WAIT_V(6); PG8_BAR;
    }
    for (;;) {
        const bool has_next = S.next(ui + 1, nxt);
        const char* nA = has_next ? (nxt.pm < g.pm2 ? (const char*)g.A + (size_t)nxt.pm * g.a_pm : (const char*)g.A2 + (size_t)(nxt.pm - g.pm2) * g.a_pm) + (size_t)nxt.pn * g.a_pn + (size_t)nxt.g * g.a_g : cA; const char* nB = has_next ? (const char*)g.Bt + (size_t)nxt.pn * g.b_pn + (size_t)nxt.g * g.b_g : cB;
        for (int t = 0; t < nt; t += 2) {
            const bool last = (t == nt - 2);
            const char* a1 = cA + (size_t)(t + 1) * kstep;
            const char* a2 = last ? nA : cA + (size_t)(t + 2) * kstep; const char* b2 = last ? nB : cB + (size_t)(t + 2) * kstep;
            const char* a3 = a2 + kstep; const char* b3 = b2 + kstep;
            if (last && has_next) S.a_ready(nxt);
            if constexpr (SP2) {
            PG8_LDB(B0, 0, 0); PG8_LDB(B1, 0, 1); PG8_SCHED; PG8_LDA(At, 0, 0); PG8_STAGE(PG8_SA(1, 1), a1 + hstepA, voffA);
            PG8_WAIT_V(8); PG8_WAIT_L(0); PG8_BAR; PG8_MMA(0, 0, At, B0); PG8_MMA(0, 1, At, B1); PG8_BAR; PG8_SCHED;
            PG8_LDA(At, 0, 1); PG8_STAGE(PG8_SB(0, 0), b2, voffB); PG8_STAGE(PG8_SB(0, 1), b2 + hstepB, voffB); PG8_STAGE(PG8_SA(0, 0), a2, voffA);
            PG8_WAIT_V(8); PG8_WAIT_L(0); PG8_BAR; PG8_MMA(1, 0, At, B0); PG8_MMA(1, 1, At, B1); PG8_BAR; PG8_SCHED;
            PG8_LDB(B0, 1, 0); PG8_LDB(B1, 1, 1); PG8_SCHED; PG8_LDA(At, 1, 0); PG8_STAGE(PG8_SA(0, 1), a2 + hstepA, voffA);
            PG8_WAIT_V(8); PG8_WAIT_L(0); PG8_BAR; PG8_MMA(0, 0, At, B0); PG8_MMA(0, 1, At, B1); PG8_BAR; PG8_SCHED;
            PG8_LDA(At, 1, 1); PG8_STAGE(PG8_SB(1, 0), b3, voffB); PG8_STAGE(PG8_SB(1, 1), b3 + hstepB, voffB); PG8_STAGE(PG8_SA(1, 0), a3, voffA);
            PG8_WAIT_V(8); PG8_WAIT_L(0); PG8_BAR; PG8_MMA(1, 0, At, B0); PG8_MMA(1, 1, At, B1); PG8_BAR; PG8_SCHED;
            } else {
            PG8_LDB(B0, 0, 0); PG8_SCHED; PG8_LDA(At, 0, 0); PG8_STAGE(PG8_SA(1, 1), a1 + hstepA, voffA);
            PG8_WAIT_L(8); PG8_BAR; PG8_WAIT_L(0); PG8_MMA(0, 0, At, B0); PG8_BAR; PG8_SCHED;
            PG8_LDB(B1, 0, 1); PG8_STAGE(PG8_SB(0, 0), b2, voffB);
            PG8_BAR; PG8_WAIT_L(0); PG8_MMA(0, 1, At, B1); PG8_BAR;
            PG8_LDA(At, 0, 1); PG8_STAGE(PG8_SA(0, 0), a2, voffA);
            PG8_BAR; PG8_WAIT_L(0); PG8_MMA(1, 0, At, B0); PG8_BAR; PG8_SCHED;
            PG8_STAGE(PG8_SB(0, 1), b2 + hstepB, voffB);
            PG8_WAIT_V(6); PG8_BAR; PG8_MMA(1, 1, At, B1); PG8_BAR;
            PG8_LDB(B0, 1, 0); PG8_SCHED; PG8_LDA(At, 1, 0); PG8_STAGE(PG8_SA(0, 1), a2 + hstepA, voffA);
            PG8_WAIT_L(8); PG8_BAR; PG8_WAIT_L(0); PG8_MMA(0, 0, At, B0); PG8_BAR; PG8_SCHED;
            PG8_LDB(B1, 1, 1); PG8_STAGE(PG8_SB(1, 0), b3, voffB);
            PG8_BAR; PG8_WAIT_L(0); PG8_MMA(0, 1, At, B1); PG8_BAR;
            PG8_LDA(At, 1, 1); PG8_STAGE(PG8_SA(1, 0), a3, voffA);
            PG8_BAR; PG8_WAIT_L(0); PG8_MMA(1, 0, At, B0); PG8_BAR; PG8_SCHED;
            PG8_STAGE(PG8_SB(1, 1), b3 + hstepB, voffB);
            PG8_WAIT_V(6); PG8_BAR; PG8_MMA(1, 1, At, B1); PG8_BAR;
            }
        }
        if constexpr (ALIGN_EPI) { if (wr == 0) PG8_BAR; }
        if constexpr (!Epi::AFTER_DRAIN) { E(acc, cur, wr, wc, fr, fq); S.done(cur); }
        if (!has_next) break;
#pragma unroll
        for (int a = 0; a < 2; ++a)
#pragma unroll
            for (int b = 0; b < 2; ++b)
#pragma unroll
                for (int m = 0; m < 4; ++m)
#pragma unroll
                    for (int n = 0; n < 2; ++n) acc[a][b][m][n] = (f32x4){0.f, 0.f, 0.f, 0.f};
        cur = nxt; cA = nA; cB = nB; ++ui;
        if constexpr (ALIGN_EPI) { if (wr == 1) PG8_BAR; }
    }
    PG8_WAIT_V(0);
    if constexpr (!ALIGN_EPI) { if (wr == 0) PG8_BAR; }
    PG8_BAR;
    if constexpr (Epi::AFTER_DRAIN) { E.fused(acc, cur, wr, wc, fr, fq, lds, wid, lane); S.done(cur); }
#undef PG8_SA
#undef PG8_SB
#undef PG8_STAGE
#undef PG8_LDA
#undef PG8_LDB
#undef PG8_MMA
#undef PG8_WAIT_V
#undef PG8_WAIT_L
#undef PG8_BAR
#undef PG8_SCHED
}
}

#define LAS __attribute__((address_space(3)))
typedef unsigned short bf16;
typedef unsigned v4u __attribute__((ext_vector_type(4)));
typedef unsigned v2u __attribute__((ext_vector_type(2)));
typedef float f32x4 __attribute__((ext_vector_type(4)));
typedef float f32x2 __attribute__((ext_vector_type(2)));
typedef short bf16x8 __attribute__((ext_vector_type(8)));
using pg8::cvt_pk_bf16; using pg8::bf_lo; using pg8::bf_hi;

constexpr int M = 49152, D = 1024, FF = 4096, NSPLIT = 3, SROWS = M / NSPLIT;
constexpr int LDS_BYTES = 147456;
constexpr size_t MiB = (size_t)1 << 20;
constexpr size_t WS_SSQ0 = 1 * MiB, WS_SSQ1 = 4 * MiB, WS_LNP = 7 * MiB, WS_RSM = 10 * MiB, WS_SSQM = 10 * MiB + 256 * 1024, WS_APOW = 11 * MiB, WS_BBAR = 13 * MiB, WS_WSB = 13 * MiB + 512 * 1024, WS_KTAB = 14 * MiB;
constexpr size_t WS_WGU1 = 16 * MiB, WS_WGU2 = 32 * MiB, WS_WD1 = 48 * MiB, WS_WD2 = 56 * MiB, WS_WQ = 64 * MiB, WS_WKV = 66 * MiB, WS_WO = 70 * MiB, WS_WIN = 72 * MiB, WS_WGLU = 75 * MiB, WS_WOUT = 76 * MiB, WS_WPOOL = 78 * MiB;
constexpr size_t WS_XB = 88 * MiB, WS_MEMB = 184 * MiB, WS_KB = 192 * MiB, WS_VT = 200 * MiB;
constexpr size_t WS_H = 208 * MiB, WS_QO = 208 * MiB, WS_POOLED = 208 * MiB, WS_ZUB = 208 * MiB, WS_ZVB = 256 * MiB, WS_SST = 304 * MiB, WS_GB = 352 * MiB, WS_AP = 400 * MiB, WS_BT = 472 * MiB, WS_B1S = 496 * MiB, WS_CAT = 400 * MiB, WS_END = 504 * MiB;

struct Args { const float* in[36]; float* out; unsigned char* ws; };

#define LDS_WAIT() asm volatile("s_waitcnt lgkmcnt(0)" ::: "memory")
__device__ __forceinline__ float wave_sum(float v) {
#pragma unroll
    for (int o = 1; o < 64; o <<= 1) v += __shfl_xor(v, o);
    return v;
}
__device__ __forceinline__ unsigned short f2bf(float f) { return (unsigned short)(cvt_pk_bf16(f, 0.f) & 0xffffu); }
__device__ __forceinline__ float rsq_eps(float ssq) { return __builtin_amdgcn_rsqf(ssq * (1.0f / 1024.0f) + 1e-6f); }

struct TD { const float* W; const float* gk; const float* gn; bf16* WT; int ldw, k0, n0, ldt, drow_off, mode; float scale; };
__device__ __forceinline__ void td_load(const TD& d, int tid, f32x4 (&v)[8]) {
#pragma unroll
    for (int i = 0; i < 8; ++i) { const int idx = tid + 512 * i, kk = idx >> 6, c4 = idx & 63; v[i] = __builtin_nontemporal_load((const f32x4*)(d.W + (size_t)(d.k0 + kk) * d.ldw + d.n0 + c4 * 4)); }
}
__device__ __forceinline__ void td_store(const TD& d, int tid, const f32x4 (&v)[8], LAS float* scr) {
#pragma unroll
    for (int i = 0; i < 8; ++i) { const int idx = tid + 512 * i, kk = idx >> 6, c4 = idx & 63; const float g = d.gk ? d.gk[d.k0 + kk] : 1.0f;
#pragma unroll
        for (int e = 0; e < 4; ++e) { const int n = c4 * 4 + e; scr[kk * 257 + (n ^ ((n >> 5) & 3))] = v[i][e] * g; } }
    __syncthreads();
#pragma unroll
    for (int j = 0; j < 4; ++j) {
        const int n = (tid >> 2) + 128 * (j >> 1), c = (tid & 3) + 4 * (j & 1), ng = d.n0 + n; const float sc = d.gn ? d.scale * d.gn[ng] : d.scale;
        const LAS float* s = scr + (8 * c) * 257 + (n ^ ((n >> 5) & 3));
        v4u o; o.x = cvt_pk_bf16(s[0 * 257] * sc, s[1 * 257] * sc); o.y = cvt_pk_bf16(s[2 * 257] * sc, s[3 * 257] * sc); o.z = cvt_pk_bf16(s[4 * 257] * sc, s[5 * 257] * sc); o.w = cvt_pk_bf16(s[6 * 257] * sc, s[7 * 257] * sc);
        const int drow = d.mode == 0 ? ng : ((ng >> 7) * 256 + (ng & 127) + (d.mode == 2 ? 128 : 0));
        *(v4u*)(d.WT + (size_t)(d.drow_off + drow) * d.ldt + d.k0 + 8 * c) = o;
    }
    __syncthreads();
}
#define TDS(W_, K_, N_, GK_, SC_, WT_, MODE_) { constexpr int nblk_ = (N_) / 256, cnt_ = ((K_) / 64) * nblk_; if (r < cnt_) { d.W = (W_); d.ldw = (N_); d.k0 = 64 * (r / nblk_); d.n0 = 256 * (r % nblk_); d.gk = (GK_); d.gn = nullptr; d.scale = (SC_); d.WT = (WT_); d.ldt = (K_); d.drow_off = 0; d.mode = (MODE_); return; } r -= cnt_; }
__device__ __forceinline__ void td_desc(const Args& a, unsigned char* ws, int l, int r, TD& d) {
    const size_t LW = (size_t)1024 * 4096;
    const float* g_f1 = a.in[4] + l * 1024; const float* g_f2 = a.in[31] + l * 1024; const float* g_cr = a.in[26] + l * 1024; const float* g_mem = a.in[27] + l * 1024;
    TDS(a.in[5] + l * LW, 1024, 4096, g_f1, 1.0f, (bf16*)(ws + WS_WGU1), 1)
    TDS(a.in[6] + l * LW, 1024, 4096, g_f1, 1.0f, (bf16*)(ws + WS_WGU1), 2)
    TDS(a.in[7] + l * LW, 4096, 1024, nullptr, 1.0f, (bf16*)(ws + WS_WD1), 0)
    TDS(a.in[32] + l * LW, 1024, 4096, g_f2, 1.0f, (bf16*)(ws + WS_WGU2), 1)
    TDS(a.in[33] + l * LW, 1024, 4096, g_f2, 1.0f, (bf16*)(ws + WS_WGU2), 2)
    TDS(a.in[34] + l * LW, 4096, 1024, nullptr, 1.0f, (bf16*)(ws + WS_WD2), 0)
    TDS(a.in[28] + (size_t)l * 1024 * 1024, 1024, 1024, g_cr, 0.0625f * 1.4426950408889634f, (bf16*)(ws + WS_WQ), 0)
    TDS(a.in[29] + (size_t)l * 1024 * 2048, 1024, 2048, g_mem, 1.0f, (bf16*)(ws + WS_WKV), 0)
    TDS(a.in[30] + (size_t)l * 1024 * 1024, 1024, 1024, nullptr, 1.0f, (bf16*)(ws + WS_WO), 0)
    if (l == 0) {
        TDS(a.in[9], 1024, 1536, a.in[8], 1.0f, (bf16*)(ws + WS_WIN), 0)
        TDS(a.in[18], 512, 512, nullptr, 1.0f, (bf16*)(ws + WS_WGLU), 0)
        TDS(a.in[23], 1024, 1024, nullptr, 1.0f, (bf16*)(ws + WS_WOUT), 0)
    }
    { const int gi = (r >> 2) & 3, kb = r & 3;
      d.W = a.in[24] + (size_t)gi * 65536; d.ldw = 256; d.k0 = 64 * kb; d.n0 = 0; d.gk = a.in[8] + 1024 + gi * 256; d.gn = a.in[25] + gi * 256; d.scale = 1.0f; d.WT = (bf16*)(ws + WS_WPOOL); d.ldt = 256; d.drow_off = gi * 256; d.mode = 0; }
}
__device__ __forceinline__ void prep_weights(const Args& a, unsigned char* ws, LAS unsigned char* lds, int l, int bx, int G, int tid, int sel) {
    tid = opq(tid);
    LAS float* scr = (LAS float*)lds;
    const int nall = 6 * 256 + 64 + 128 + 64 + (l == 0 ? 96 + 16 + 64 : 16);
    const int nitems = sel == 0 ? nall : sel == 1 ? 768 + (nall - 1536) : sel == 2 ? 512 : 256;
#define PW_MAP(i_) (sel == 0 ? (i_) : sel == 1 ? ((i_) < 768 ? (i_) : (i_) + 768) : sel == 2 ? (i_) + 768 : (i_) + 1280)
    int it = bx; if (it >= nitems) return;
    TD cur; td_desc(a, ws, l, PW_MAP(it), cur);
    f32x4 v[8]; td_load(cur, tid, v);
    for (;;) {
        const int itn = it + G; const bool more = itn < nitems;
        TD nxt = cur; f32x4 vn[8];
        if (more) { td_desc(a, ws, l, PW_MAP(itn), nxt); td_load(nxt, tid, vn); }
        td_store(cur, tid, v, scr);
        if (!more) break;
#pragma unroll
        for (int i = 0; i < 8; ++i) v[i] = vn[i];
        cur = nxt; it = itn;
    }
#undef PW_MAP
}

__device__ __forceinline__ void sincos_turns(double t, double& c, double& s) {
    t -= __builtin_rint(t);
    const double n = __builtin_rint(4.0 * t); const double r = t - 0.25 * n; const double x = 6.283185307179586476925 * r, x2 = x * x;
    double sp = -7.647163731819816e-13; sp = sp * x2 + 1.605904383682161e-10; sp = sp * x2 - 2.505210838544172e-08; sp = sp * x2 + 2.755731922398589e-06; sp = sp * x2 - 1.984126984126984e-04; sp = sp * x2 + 8.333333333333333e-03; sp = sp * x2 - 1.666666666666667e-01; sp = sp * x2 * x + x;
    double cp = 4.779477332387385e-14; cp = cp * x2 - 1.147074559772972e-11; cp = cp * x2 + 2.087675698786810e-09; cp = cp * x2 - 2.755731922398589e-07; cp = cp * x2 + 2.480158730158730e-05; cp = cp * x2 - 1.388888888888889e-03; cp = cp * x2 + 4.166666666666666e-02; cp = cp * x2 - 0.5; cp = cp * x2 + 1.0;
    const int q = ((int)n) & 3;
    c = (q == 0) ? cp : (q == 1) ? -sp : (q == 2) ? -cp : sp;
    s = (q == 0) ? sp : (q == 1) ? cp : (q == 2) ? -sp : -cp;
}
__device__ __forceinline__ void prep_misc(const Args& a, unsigned char* ws, int gw, int NGW, int gt, int NT, int lane) {
    gw = opq(gw); gt = opq(gt); lane = opq(lane);
    bf16* XB = (bf16*)(ws + WS_XB); float* SSQ0 = (float*)(ws + WS_SSQ0);
    for (int r0 = gw; r0 < M; r0 += 4 * NGW) {
        f32x4 v[4][4];
#pragma unroll
        for (int q = 0; q < 4; ++q) { const int r = r0 + q * NGW < M ? r0 + q * NGW : r0; const float* src = r < 32768 ? a.in[0] + (size_t)r * D : a.in[1] + (size_t)(r - 32768) * D;
#pragma unroll
            for (int j = 0; j < 4; ++j) v[q][j] = __builtin_nontemporal_load((const f32x4*)src + lane + 64 * j); }
#pragma unroll
        for (int q = 0; q < 4; ++q) { const int r = r0 + q * NGW < M ? r0 + q * NGW : r0; float s = 0.f;
#pragma unroll
            for (int j = 0; j < 4; ++j) { const f32x4 x = v[q][j]; s += (x[0] * x[0] + x[1] * x[1]) + (x[2] * x[2] + x[3] * x[3]);
                v2u w; w.x = cvt_pk_bf16(x[0], x[1]); w.y = cvt_pk_bf16(x[2], x[3]); ((v2u*)(XB + (size_t)r * D))[lane + 64 * j] = w; }
            s = wave_sum(s);
            if (lane < 16) SSQ0[(size_t)r * 16 + lane] = lane == 0 ? s : 0.f; }
    }
    bf16* MEMB = (bf16*)(ws + WS_MEMB); float* SSQM = (float*)(ws + WS_SSQM); float* RSM = (float*)(ws + WS_RSM);
    for (int r = gw; r < 4096; r += NGW) {
        const float* src = r < 2048 ? a.in[2] + (size_t)r * D : a.in[3] + (size_t)(r - 2048) * D;
        float s = 0.f;
#pragma unroll
        for (int j = 0; j < 4; ++j) { const f32x4 v = __builtin_nontemporal_load((const f32x4*)src + lane + 64 * j); s += (v[0] * v[0] + v[1] * v[1]) + (v[2] * v[2] + v[3] * v[3]);
            v2u w; w.x = cvt_pk_bf16(v[0], v[1]); w.y = cvt_pk_bf16(v[2], v[3]); ((v2u*)(MEMB + (size_t)r * D))[lane + 64 * j] = w; }
        s = wave_sum(s);
        if (lane < 16) SSQM[(size_t)r * 16 + lane] = lane == 0 ? s : 0.f;
        if (lane == 0) RSM[r] = rsq_eps(s);
    }
    { bf16* WSB = (bf16*)(ws + WS_WSB); for (int i = gt; i < 4 * 128 * 128; i += NT) WSB[i] = f2bf(a.in[21][i]); }
    f32x2* APOW = (f32x2*)(ws + WS_APOW); f32x2* BBAR = (f32x2*)(ws + WS_BBAR);
    for (int it = gt; it < 2 * 32 * 64 * 33; it += NT) {
        const int idx = it & 4095, k = it >> 12, p = idx & 63, dg = idx >> 6;
        const double lre = (double)a.in[10][idx], lim = (double)a.in[11][idx]; const double dt = exp((double)a.in[12][dg]);
        const double lr = lre * dt, tn = lim * dt * 0.15915494309189533577;
        const double mag = exp((double)k * lr); double c, s; sincos_turns((double)k * tn, c, s);
        APOW[((size_t)dg * 33 + k) * 64 + p] = (f32x2){(float)(mag * c), (float)(mag * s)};
        if (k == 1) {
            const double a1r = mag * c, a1i = mag * s;
            const double nr = a1r - 1.0, ni = a1i, den = lre * lre + lim * lim; const double qr = (nr * lre + ni * lim) / den, qi = (ni * lre - nr * lim) / den;
#pragma unroll 4
            for (int cc = 0; cc < 16; ++cc) { const double br = (double)a.in[13][(size_t)idx * 16 + cc], bi = (double)a.in[14][(size_t)idx * 16 + cc]; BBAR[(size_t)idx * 16 + cc] = (f32x2){(float)(qr * br - qi * bi), (float)(qr * bi + qi * br)}; }
        }
    }
}
__device__ __forceinline__ void s5_tab2(const Args& a, unsigned char* ws, int gt, int NT) {
    gt = opq(gt);
    const f32x2* APOW = (const f32x2*)(ws + WS_APOW); const f32x2* BBAR = (const f32x2*)(ws + WS_BBAR); float* KTAB = (float*)(ws + WS_KTAB);
    for (int e = gt; e < 32 * 2 * 32 * 256; e += NT) {
        const int cc = e & 15, c = (e >> 4) & 15, k = (e >> 8) & 31, dir = (e >> 13) & 1, g = e >> 14, dg = dir * 32 + g;
        const f32x2* ap = APOW + ((size_t)dg * 33 + k) * 64; const float* cre = a.in[15] + ((size_t)dg * 16 + c) * 64; const float* cim = a.in[16] + ((size_t)dg * 16 + c) * 64; const f32x2* bb = BBAR + (size_t)dg * 1024 + cc;
        float acc = 0.f;
#pragma unroll 8
        for (int p = 0; p < 64; ++p) { const f32x2 av = ap[p]; const float cr = cre[p], ci = cim[p]; const float car = cr * av.x - ci * av.y, cai = cr * av.y + ci * av.x; const f32x2 b = bb[p * 16]; acc += car * b.x - cai * b.y; }
        KTAB[e] = acc;
    }
}
__device__ __forceinline__ void s5_tab3(const Args& a, unsigned char* ws, int gt, int NT) {
    gt = opq(gt);
    const f32x2* APOW = (const f32x2*)(ws + WS_APOW); const f32x2* BBAR = (const f32x2*)(ws + WS_BBAR); const float* KTAB = (const float*)(ws + WS_KTAB);
    bf16* BT = (bf16*)(ws + WS_BT); bf16* B1S = (bf16*)(ws + WS_B1S);
    for (int idx = gt; idx < 32 * 512 * 96; idx += NT) {
        const int kp = idx % 96, n = (idx / 96) & 511, g = idx / (96 * 512), t = n >> 4, c = n & 15;
        float v[8];
        if (kp < 64) {
            const int s = kp >> 1, c0 = (kp & 1) * 8;
            if (s != t) { const int dir = s < t ? 0 : 1, k = s < t ? t - s : s - t; const f32x4* kt = (const f32x4*)(KTAB + ((size_t)((g * 2 + dir) * 32 + k) * 256 + c * 16 + c0)); const f32x4 x0 = kt[0], x1 = kt[1];
                v[0] = x0[0]; v[1] = x0[1]; v[2] = x0[2]; v[3] = x0[3]; v[4] = x1[0]; v[5] = x1[1]; v[6] = x1[2]; v[7] = x1[3]; }
            else { const f32x4* k0 = (const f32x4*)(KTAB + ((size_t)((g * 2 + 0) * 32) * 256 + c * 16 + c0)); const f32x4* k1 = (const f32x4*)(KTAB + ((size_t)((g * 2 + 1) * 32) * 256 + c * 16 + c0));
                const f32x4 x0 = k0[0] + k1[0], x1 = k0[1] + k1[1]; const float dv = a.in[17][g * 16 + c];
                v[0] = x0[0]; v[1] = x0[1]; v[2] = x0[2]; v[3] = x0[3]; v[4] = x1[0]; v[5] = x1[1]; v[6] = x1[2]; v[7] = x1[3];
#pragma unroll
                for (int i = 0; i < 8; ++i) v[i] += (c == c0 + i) ? dv : 0.f; }
        } else {
            const int j = kp - 64, dir = j >> 4, i8 = (j & 15) * 8, im = i8 >> 6, p0 = i8 & 63, e = dir == 0 ? t + 1 : 32 - t, dg = dir * 32 + g;
            const f32x2* ap = APOW + ((size_t)dg * 33 + e) * 64 + p0; const float* cre = a.in[15] + ((size_t)dg * 16 + c) * 64 + p0; const float* cim = a.in[16] + ((size_t)dg * 16 + c) * 64 + p0;
#pragma unroll
            for (int i = 0; i < 8; ++i) { const f32x2 av = ap[i]; const float cr = cre[i], ci = cim[i]; v[i] = im ? -(cr * av.y + ci * av.x) : (cr * av.x - ci * av.y); }
        }
        v4u o; o.x = cvt_pk_bf16(v[0], v[1]); o.y = cvt_pk_bf16(v[2], v[3]); o.z = cvt_pk_bf16(v[4], v[5]); o.w = cvt_pk_bf16(v[6], v[7]);
        *(v4u*)(BT + ((size_t)(g * 512 + n) * 768 + kp * 8)) = o;
    }
    for (int idx = gt; idx < 32 * 256 * 64; idx += NT) {
        const int kp = idx & 63, n = (idx >> 6) & 255, g = idx >> 14, s = kp >> 1, c0 = (kp & 1) * 8, dir = n >> 7, im = (n >> 6) & 1, p = n & 63, e = dir == 0 ? 31 - s : s, dg = dir * 32 + g;
        const f32x2 av = APOW[((size_t)dg * 33 + e) * 64 + p]; const f32x2* bb = BBAR + ((size_t)dg * 64 + p) * 16 + c0;
        float v[8];
#pragma unroll
        for (int i = 0; i < 8; ++i) { const f32x2 b = bb[i]; v[i] = im ? (av.x * b.y + av.y * b.x) : (av.x * b.x - av.y * b.y); }
        v4u o; o.x = cvt_pk_bf16(v[0], v[1]); o.y = cvt_pk_bf16(v[2], v[3]); o.z = cvt_pk_bf16(v[4], v[5]); o.w = cvt_pk_bf16(v[6], v[7]);
        *(v4u*)(B1S + ((size_t)(g * 256 + n) * 512 + kp * 8)) = o;
    }
}
__device__ __forceinline__ void s5_scan(unsigned char* ws, int gt) {
    gt = opq(gt);
    if (gt >= 16 * 32 * 2 * 64) return;
    const int p = gt & 63, dir = (gt >> 6) & 1, g = (gt >> 7) & 31, seq = gt >> 12;
    const int ch0 = seq < 8 ? seq * 128 : 1024 + (seq - 8) * 64, nch = seq < 8 ? 128 : 64;
    const f32x2 a32 = ((const f32x2*)(ws + WS_APOW))[((size_t)(dir * 32 + g) * 33 + 32) * 64 + p];
    const float* S = (const float*)(ws + WS_SST) + (size_t)g * 1536 * 256 + dir * 128 + p; bf16* AP = (bf16*)(ws + WS_AP) + (size_t)g * 1536 * 768 + 512 + dir * 128 + p;
    float hr = 0.f, hi = 0.f;
#pragma unroll 8
    for (int i = 0; i < nch; ++i) {
        const int ch = ch0 + (dir == 0 ? i : nch - 1 - i);
        const float sr = S[(size_t)ch * 256], si = S[(size_t)ch * 256 + 64];
        AP[(size_t)ch * 768] = f2bf(hr); AP[(size_t)ch * 768 + 64] = f2bf(hi);
        const float nr = a32.x * hr - a32.y * hi + sr, ni = a32.x * hi + a32.y * hr + si; hr = nr; hi = ni;
    }
}
__device__ __forceinline__ void sgu_phase(LAS unsigned char* lds, const Args& a, unsigned char* ws, int ubeg, int uend, int rel, int nrel, int tid) {
    if (rel < 0) return;
    const int tid0 = tid;
    const bf16* ZUB = (const bf16*)(ws + WS_ZUB); const bf16* ZVB = (const bf16*)(ws + WS_ZVB); const float* LNP = (const float*)(ws + WS_LNP); const bf16* WSB = (const bf16*)(ws + WS_WSB); bf16* CAT = (bf16*)a.out;
    const float* ng = a.in[19]; const float* nb = a.in[20]; const float* bs = a.in[22];
    LAS bf16* VTl = (LAS bf16*)lds;
    for (int unit = ubeg + rel; unit < uend; unit += nrel) {
        const int tid = opq(tid0), lane = tid & 63, wave = tid >> 6, fr = lane & 15, fq = lane >> 4;
        const int ck = unit >> 2, h = unit & 3, tok0 = ck * 128, j = tid >> 2;
        float s1 = 0.f, s2 = 0.f;
        { const f32x4* lp = (const f32x4*)(LNP + (size_t)(tok0 + j) * 16);
#pragma unroll
          for (int q = 0; q < 4; ++q) { const f32x4 v = lp[q]; s1 += v[0] + v[2]; s2 += v[1] + v[3]; } }
        const float mean = s1 * (1.0f / 512.0f), var = s2 * (1.0f / 512.0f) - mean * mean, rstd = __builtin_amdgcn_rsqf(var + 1e-6f);
#pragma unroll
        for (int it = 0; it < 4; ++it) {
            const int d0 = ((tid & 3) + 4 * it) * 8;
            const v4u raw = *(const v4u*)(ZVB + (size_t)(tok0 + j) * 512 + h * 128 + d0);
            const f32x4 g0 = *(const f32x4*)(ng + h * 128 + d0), g1 = *(const f32x4*)(ng + h * 128 + d0 + 4), b0 = *(const f32x4*)(nb + h * 128 + d0), b1 = *(const f32x4*)(nb + h * 128 + d0 + 4);
            float x[8] = {bf_lo(raw.x), bf_hi(raw.x), bf_lo(raw.y), bf_hi(raw.y), bf_lo(raw.z), bf_hi(raw.z), bf_lo(raw.w), bf_hi(raw.w)};
#pragma unroll
            for (int e = 0; e < 8; ++e) { const float gg = e < 4 ? g0[e & 3] : g1[e & 3], bb = e < 4 ? b0[e & 3] : b1[e & 3]; VTl[(d0 + e) * 136 + j] = f2bf((x[e] - mean) * rstd * gg + bb); }
        }
        __syncthreads();
        bf16x8 wsf[4];
#pragma unroll
        for (int kk = 0; kk < 4; ++kk) wsf[kk] = *(const bf16x8*)(WSB + (size_t)(h * 128 + wave * 16 + fr) * 128 + 32 * kk + 8 * fq);
        f32x4 acc[8];
#pragma unroll
        for (int dt = 0; dt < 8; ++dt) acc[dt] = (f32x4){0.f, 0.f, 0.f, 0.f};
#pragma unroll
        for (int kk = 0; kk < 4; ++kk)
#pragma unroll
            for (int dt = 0; dt < 8; ++dt) { const bf16x8 vf = *(const LAS bf16x8*)(VTl + (16 * dt + fr) * 136 + 32 * kk + 8 * fq); acc[dt] = __builtin_amdgcn_mfma_f32_16x16x32_bf16(vf, wsf[kk], acc[dt], 0, 0, 0); }
        const int token = tok0 + wave * 16 + fr; const float bias = bs[h * 128 + wave * 16 + fr];
#pragma unroll
        for (int dt = 0; dt < 8; ++dt) { const int d = 16 * dt + 4 * fq; const v2u ub = *(const v2u*)(ZUB + (size_t)token * 512 + h * 128 + d);
            v2u o; o.x = cvt_pk_bf16(bf_lo(ub.x) * (acc[dt][0] + bias), bf_hi(ub.x) * (acc[dt][1] + bias)); o.y = cvt_pk_bf16(bf_lo(ub.y) * (acc[dt][2] + bias), bf_hi(ub.y) * (acc[dt][3] + bias));
            *(v2u*)(CAT + (size_t)token * 1024 + 512 + h * 128 + d) = o; }
        __syncthreads();
    }
}
__device__ __forceinline__ void pool_phase(LAS unsigned char* lds, const bf16* XB, const float* part, bf16* P, int G, int bx, int tid0) {
    LAS float* tile = (LAS float*)lds;
    LAS float* rsl = (LAS float*)(lds + 98304);
    const int vcu = (G % 8 == 0) ? (bx % 8) * (G / 8) + bx / 8 : bx;
    for (int unit = vcu; unit < 3072; unit += G) {
        const int tid = opq(tid0);
        const int t0 = (unit >> 1) * 32, hf = unit & 1; const int seq0 = t0 < 32768 ? (t0 & ~4095) : (t0 & ~2047), L = t0 < 32768 ? 4096 : 2048;
        __syncthreads();
        if (tid < 48) { int r = t0 - 8 + tid; r = r < 0 ? 0 : (r > M - 1 ? M - 1 : r); const f32x4* pp = (const f32x4*)(part + (size_t)r * 16); const f32x4 s4 = (pp[0] + pp[1]) + (pp[2] + pp[3]); rsl[tid] = rsq_eps((s4[0] + s4[1]) + (s4[2] + s4[3])); }
        v2u v[12];
#pragma unroll
        for (int i = 0; i < 12; ++i) { const int idx = tid + 512 * i, row = idx >> 7, q = idx & 127; int r = t0 - 8 + row; r = r < 0 ? 0 : (r > M - 1 ? M - 1 : r); v[i] = __builtin_nontemporal_load((const v2u*)(XB + (size_t)r * 1024 + hf * 512 + q * 4)); }
        __syncthreads();
#pragma unroll
        for (int i = 0; i < 12; ++i) { const int idx = tid + 512 * i, row = idx >> 7, q = idx & 127; *(LAS f32x4*)(tile + row * 512 + q * 4) = (f32x4){bf_lo(v[i].x), bf_hi(v[i].x), bf_lo(v[i].y), bf_hi(v[i].y)} * rsl[row]; }
        __syncthreads();
        const int q = tid & 127, rg = tid >> 7, ch0 = hf * 512 + q * 4, gi = ch0 >> 8, hw = 1 << gi;
        int pos = t0 + rg * 8 - seq0; const int lr0 = 8 - (t0 - seq0);
#define TL(p_) (*(const LAS f32x4*)(tile + ((p_) + lr0) * 512 + q * 4))
        f32x4 s = (f32x4){0.f, 0.f, 0.f, 0.f};
        { const int lo = pos - hw < 0 ? 0 : pos - hw, hi = pos + hw > L ? L : pos + hw; for (int j2 = lo; j2 < hi; ++j2) s += TL(j2); }
#pragma unroll
        for (int i = 0; i < 8; ++i, ++pos) {
            const int lo = pos - hw < 0 ? 0 : pos - hw, hi = pos + hw > L ? L : pos + hw;
            const f32x4 o = s * (1.0f / (float)(hi - lo)) - TL(pos);
            v2u w; w.x = cvt_pk_bf16(o[0], o[1]); w.y = cvt_pk_bf16(o[2], o[3]); *(v2u*)(P + (size_t)(seq0 + pos) * 1024 + ch0) = w;
            if (i < 7) { if (pos + hw < L) s += TL(pos + hw); if (pos - hw >= 0) s -= TL(pos - hw); }
        }
#undef TL
    }
}
__device__ __forceinline__ void attn_phase(LAS unsigned char* lds, const bf16* QO, bf16* OB, const bf16* KB, const bf16* VT, int G, int bx, int tid) {
    constexpr int BUF = 69632;
    const int tid0 = tid;
    const int vcu = (G % 8 == 0) ? (bx % 8) * (G / 8) + bx / 8 : bx;
    for (int unit = vcu; unit < 768; unit += G) {
        const int tid = opq(tid0), lane = tid & 63, wave = tid >> 6, fr = lane & 15, fq = lane >> 4;
        int b16, h, row0;
        if (unit < 512) { b16 = unit >> 6; h = (unit >> 4) & 3; row0 = b16 * 4096 + (unit & 15) * 256; }
        else { const int u2 = unit - 512; b16 = 8 + (u2 >> 5); h = (u2 >> 3) & 3; row0 = 32768 + (b16 - 8) * 2048 + (u2 & 7) * 256; }
        const size_t qoff = (size_t)(row0 + wave * 32 + fr) * 1024 + h * 256;
        bf16x8 qf[2][8];
#pragma unroll
        for (int t = 0; t < 2; ++t)
#pragma unroll
            for (int kk = 0; kk < 8; ++kk) qf[t][kk] = *(const bf16x8*)(QO + qoff + (size_t)t * 16 * 1024 + 32 * kk + 8 * fq);
        const bf16* kbase = KB + (size_t)(b16 * 256) * 1024 + h * 256;
#pragma unroll
        for (int hh = 0; hh < 2; ++hh) {
            v4u tmp[8];
#pragma unroll
            for (int it = 0; it < 8; ++it) tmp[it] = *(const v4u*)(kbase + (size_t)(hh * 128 + (tid >> 5) + 16 * it) * 1024 + (tid & 31) * 8);
#pragma unroll
            for (int it = 0; it < 8; ++it) *(LAS v4u*)(lds + hh * BUF + ((tid >> 5) + 16 * it) * 528 + (tid & 31) * 16) = tmp[it];
        }
        __syncthreads();
        f32x4 sacc[2][16];
#pragma unroll
        for (int n = 0; n < 16; ++n) { sacc[0][n] = (f32x4){0.f, 0.f, 0.f, 0.f}; sacc[1][n] = (f32x4){0.f, 0.f, 0.f, 0.f}; }
        {
#define KRD(i_) (*(const LAS bf16x8*)(lds + ((i_) >> 6) * BUF + ((((i_) >> 3) & 7) * 16 + fr) * 528 + (32 * ((i_) & 7) + 8 * fq) * 2))
            bf16x8 kfb[4];
#pragma unroll
            for (int i = 0; i < 4; ++i) kfb[i] = KRD(i);
#pragma unroll
            for (int i = 0; i < 128; ++i) { const bf16x8 c = kfb[i & 3]; if (i + 4 < 128) kfb[i & 3] = KRD(i + 4);
                sacc[0][i >> 3] = __builtin_amdgcn_mfma_f32_16x16x32_bf16(c, qf[0][i & 7], sacc[0][i >> 3], 0, 0, 0); sacc[1][i >> 3] = __builtin_amdgcn_mfma_f32_16x16x32_bf16(c, qf[1][i & 7], sacc[1][i >> 3], 0, 0, 0); }
#undef KRD
        }
        __syncthreads();
        const bf16* vbase = VT + (size_t)(h * 256) * 4096 + b16 * 256;
#pragma unroll
        for (int hh = 0; hh < 2; ++hh) {
            v4u tmp[8];
#pragma unroll
            for (int it = 0; it < 8; ++it) tmp[it] = *(const v4u*)(vbase + (size_t)((tid >> 4) + 32 * it) * 4096 + hh * 128 + (tid & 15) * 8);
#pragma unroll
            for (int it = 0; it < 8; ++it) *(LAS v4u*)(lds + hh * BUF + ((tid >> 4) + 32 * it) * 272 + (tid & 15) * 16) = tmp[it];
        }
        bf16x8 pf[2][8]; float inv[2];
#pragma unroll
        for (int t = 0; t < 2; ++t) {
            float mx = -3.0e38f;
#pragma unroll
            for (int n = 0; n < 16; ++n) mx = fmaxf(fmaxf(mx, fmaxf(sacc[t][n][0], sacc[t][n][1])), fmaxf(sacc[t][n][2], sacc[t][n][3]));
            mx = fmaxf(mx, __shfl_xor(mx, 16)); mx = fmaxf(mx, __shfl_xor(mx, 32));
            float lsum = 0.f;
#pragma unroll
            for (int n = 0; n < 16; ++n) {
#pragma unroll
                for (int e = 0; e < 4; ++e) { const float pv = __builtin_amdgcn_exp2f(sacc[t][n][e] - mx); sacc[t][n][e] = pv; lsum += pv; } }
            lsum += __shfl_xor(lsum, 16); lsum += __shfl_xor(lsum, 32);
            inv[t] = __builtin_amdgcn_rcpf(lsum);
#pragma unroll
            for (int kk = 0; kk < 8; ++kk) { v4u w; w.x = cvt_pk_bf16(sacc[t][2 * kk][0], sacc[t][2 * kk][1]); w.y = cvt_pk_bf16(sacc[t][2 * kk][2], sacc[t][2 * kk][3]); w.z = cvt_pk_bf16(sacc[t][2 * kk + 1][0], sacc[t][2 * kk + 1][1]); w.w = cvt_pk_bf16(sacc[t][2 * kk + 1][2], sacc[t][2 * kk + 1][3]); pf[t][kk] = __builtin_bit_cast(bf16x8, w); }
        }
        __syncthreads();
        {
#define VRD(i_, off_) (*(const LAS v2u*)(lds + (((i_) & 7) >> 2) * BUF + (16 * ((i_) >> 3) + fr) * 272 + ((((i_) & 7) & 3) * 32 + 4 * fq) * 2 + (off_)))
            v2u vlo[4], vhi[4];
#pragma unroll
            for (int i = 0; i < 4; ++i) { vlo[i] = VRD(i, 0); vhi[i] = VRD(i, 32); }
            f32x4 o0 = (f32x4){0.f, 0.f, 0.f, 0.f}, o1 = (f32x4){0.f, 0.f, 0.f, 0.f};
#pragma unroll
            for (int i = 0; i < 128; ++i) {
                v4u w; w.x = vlo[i & 3].x; w.y = vlo[i & 3].y; w.z = vhi[i & 3].x; w.w = vhi[i & 3].y; const bf16x8 vf = __builtin_bit_cast(bf16x8, w);
                if (i + 4 < 128) { vlo[i & 3] = VRD(i + 4, 0); vhi[i & 3] = VRD(i + 4, 32); }
                o0 = __builtin_amdgcn_mfma_f32_16x16x32_bf16(vf, pf[0][i & 7], o0, 0, 0, 0); o1 = __builtin_amdgcn_mfma_f32_16x16x32_bf16(vf, pf[1][i & 7], o1, 0, 0, 0);
                if ((i & 7) == 7) { const int dt = i >> 3;
                    v2u ow; ow.x = cvt_pk_bf16(o0[0] * inv[0], o0[1] * inv[0]); ow.y = cvt_pk_bf16(o0[2] * inv[0], o0[3] * inv[0]);
                    *(v2u*)(OB + qoff + 16 * dt + 4 * fq) = ow;
                    ow.x = cvt_pk_bf16(o1[0] * inv[1], o1[1] * inv[1]); ow.y = cvt_pk_bf16(o1[2] * inv[1], o1[3] * inv[1]);
                    *(v2u*)(OB + qoff + (size_t)16 * 1024 + 16 * dt + 4 * fq) = ow;
                    o0 = (f32x4){0.f, 0.f, 0.f, 0.f}; o1 = (f32x4){0.f, 0.f, 0.f, 0.f}; }
            }
#undef VRD
        }
        __syncthreads();
    }
}

#define XB_TMO      128
#define XB_XCNT(j)  (256  + 64 * (j))
#define XB_XSUB(j)  (1280 + 64 * (j))
#define XB_XGEN(j)  (2304 + 64 * (j))
#define XB_TOP      3328
#define XB_TOPGEN   3392
#define XCD_BAR_WORDS 3456
#define XB_SPIN_CAP (1u << 18)

__device__ __forceinline__ unsigned xb_ld(unsigned* p)              { return __hip_atomic_load(p, __ATOMIC_RELAXED, __HIP_MEMORY_SCOPE_AGENT); }
__device__ __forceinline__ unsigned xb_add(unsigned* p, unsigned v) { return __hip_atomic_fetch_add(p, v, __ATOMIC_RELAXED, __HIP_MEMORY_SCOPE_AGENT); }
__device__ __forceinline__ unsigned xb_xcc_id() { return (unsigned)__builtin_amdgcn_s_getreg((3 << 11) | 20) & 0xFu; }
#define XB_SPIN(cond, bar) do { unsigned _sp = 0; while (cond) { __builtin_amdgcn_s_sleep(1); \
    if ((++_sp & 255u) == 0u) { if (xb_ld(&(bar)[XB_TMO])) break; if (_sp > XB_SPIN_CAP) { atomicAdd(&(bar)[XB_TMO], 1u); break; } } } } while (0)

struct XcdBarrier {
    unsigned* bar; unsigned x;
    volatile LAS unsigned* st;
};

__device__ __forceinline__ XcdBarrier xcd_barrier_post(unsigned* bar, volatile LAS unsigned* st) {
    XcdBarrier b; b.bar = bar; b.x = xb_xcc_id(); b.st = st;
    if (threadIdx.x == 0) (void)xb_add(&bar[XB_XCNT(b.x)], 1u);
    return b;
}
__device__ __forceinline__ void xcd_barrier_complete(unsigned* bar, unsigned x, unsigned& nloc, unsigned& nx) {
    const unsigned G = gridDim.x * gridDim.y * gridDim.z;
    unsigned sum, cnt, mine, sp = 0u;
    for (;;) {
        sum = 0u; cnt = 0u; mine = 0u;
#pragma unroll
        for (unsigned j = 0; j < 16; ++j) { const unsigned c = xb_ld(&bar[XB_XCNT(j)]); sum += c; cnt += (c > 0u) ? 1u : 0u; mine = (j == x) ? c : mine; }
        if (sum == G) break;
        __builtin_amdgcn_s_sleep(1);
        if ((++sp & 255u) == 0u) { if (xb_ld(&bar[XB_TMO])) break; if (sp > XB_SPIN_CAP) { atomicAdd(&bar[XB_TMO], 1u); break; } }
    }
    nloc = mine > 0u ? mine : 1u; nx = cnt > 0u ? cnt : 1u;
}

__device__ __forceinline__ void xcd_barrier(const XcdBarrier& b) {
    asm volatile("s_waitcnt vmcnt(0)" ::: "memory");
    __syncthreads();
    if (threadIdx.x == 0) {
        unsigned* bar = b.bar;
        __builtin_amdgcn_s_waitcnt(0);
        unsigned nloc = b.st[0], nx = b.st[1];
        if (nloc == 0u) { xcd_barrier_complete(bar, b.x, nloc, nx); b.st[0] = nloc; b.st[1] = nx; }
        const unsigned old = xb_add(&bar[XB_XSUB(b.x)], 1u);
        const unsigned gen = old / nloc;
        if (old + 1u == (gen + 1u) * nloc) {
            __builtin_amdgcn_fence(__ATOMIC_RELEASE, "agent");
            asm volatile("s_waitcnt vmcnt(0)" ::: "memory");
            const unsigned og = xb_add(&bar[XB_TOP], 1u);
            const unsigned tg = og / nx;
            if (og + 1u == (tg + 1u) * nx) xb_add(&bar[XB_TOPGEN], 1u);
            else XB_SPIN(xb_ld(&bar[XB_TOPGEN]) == tg, bar);
            __builtin_amdgcn_fence(__ATOMIC_ACQUIRE, "agent");
            xb_add(&bar[XB_XGEN(b.x)], 1u);
            asm volatile("s_waitcnt vmcnt(0)" ::: "memory");
        } else {
            XB_SPIN(xb_ld(&bar[XB_XGEN(b.x)]) == gen, bar);
            __builtin_amdgcn_fence(__ATOMIC_ACQUIRE, "agent");
            asm volatile("s_waitcnt vmcnt(0)" ::: "memory");
        }
    }
    __syncthreads();
}

__device__ __forceinline__ void final_phase(float* OUT, const bf16* XB, const float* part, const float* gain, int gw, int NGW, int lane) {
    gw = opq(gw); lane = opq(lane);
    f32x4 g[4];
#pragma unroll
    for (int j = 0; j < 4; ++j) g[j] = ((const f32x4*)gain)[lane + 64 * j];
    for (int r0 = gw; r0 < M; r0 += 4 * NGW) {
        v2u w[4][4]; float s[4];
#pragma unroll
        for (int q = 0; q < 4; ++q) { const int r = r0 + q * NGW < M ? r0 + q * NGW : r0; s[q] = lane < 16 ? part[(size_t)r * 16 + lane] : 0.f;
#pragma unroll
            for (int j = 0; j < 4; ++j) w[q][j] = __builtin_nontemporal_load((const v2u*)(XB + (size_t)r * D) + lane + 64 * j); }
#pragma unroll
        for (int q = 0; q < 4; ++q) { const int r = r0 + q * NGW < M ? r0 + q * NGW : r0; const float rs = rsq_eps(wave_sum(s[q]));
#pragma unroll
            for (int j = 0; j < 4; ++j) { const f32x4 v = (f32x4){bf_lo(w[q][j].x), bf_hi(w[q][j].x), bf_lo(w[q][j].y), bf_hi(w[q][j].y)} * g[j] * rs; __builtin_nontemporal_store(v, (f32x4*)(OUT + (size_t)r * D) + lane + 64 * j); } }
    }
}

#define XBAR() do { xcd_barrier(bar); if (REP_BAR) xcd_barrier(bar); } while (0)
#ifndef REP_A
#define REP_A 0
#endif
#ifndef REP_Q
#define REP_Q 0
#endif
#ifndef REP_KV
#define REP_KV 0
#endif
#ifndef REP_SCAN
#define REP_SCAN 0
#endif
#ifndef REP_SGU
#define REP_SGU 0
#endif
#ifndef REP_WIN
#define REP_WIN 0
#endif
#ifndef REP_TAB
#define REP_TAB 0
#endif
#ifndef REP_BAR
#define REP_BAR 0
#endif
#ifndef REP_PREP
#define REP_PREP 0
#endif
#ifndef REP_S5
#define REP_S5 0
#endif
#ifndef REP_ATT
#define REP_ATT 0
#endif
#ifndef REP_RES
#define REP_RES 0
#endif
#define REPEAT(flag_, ...) do { __VA_ARGS__ if (flag_) { __VA_ARGS__ } } while (0)
#ifndef REP_GU
#define REP_GU 0
#endif
#ifndef REP_DOWN
#define REP_DOWN 0
#endif
#define GEMM(EPI, g_, nM_, nN_, nG_, c_, E_) do { pg8::Order S_; S_.init(nM_, nN_, nG_, G, c_); pg8::gemm_phase<EPI, pg8::Order, true, true>(lds, g_, S_, E_); } while (0)
#define GEMM_NA(EPI, g_, nM_, nN_, nG_, c_, E_) do { pg8::Order S_; S_.init(nM_, nN_, nG_, G, c_); pg8::gemm_phase<EPI, pg8::Order, false, true>(lds, g_, S_, E_); } while (0)

__global__ void __launch_bounds__(512, 2) mk_fwd(Args a) {
    extern __shared__ __attribute__((aligned(16))) unsigned char lds_raw[];
    LAS unsigned char* lds = (LAS unsigned char*)lds_raw;
    cg::grid_group grid = cg::this_grid();
    const int tid = threadIdx.x, lane = tid & 63, wave = __builtin_amdgcn_readfirstlane(tid >> 6);
    const int G = gridDim.x, bx = blockIdx.x;
    const int gw = bx * 8 + wave, NGW = G * 8, gt = bx * 512 + tid, NT = G * 512;
    unsigned char* ws = a.ws;
    float* X = a.out;
    bf16* XB = (bf16*)(ws + WS_XB); bf16* H = (bf16*)(ws + WS_H); bf16* QO = (bf16*)(ws + WS_QO); bf16* MEMB = (bf16*)(ws + WS_MEMB); bf16* KB = (bf16*)(ws + WS_KB); bf16* VT = (bf16*)(ws + WS_VT);
    bf16* WKV = (bf16*)(ws + WS_WKV);
#define SSQ(i) ((float*)(ws + ((i) ? WS_SSQ1 : WS_SSQ0)))
    constexpr size_t T1K = (size_t)256 * 1024 * 2;

    volatile LAS unsigned* bst = (volatile LAS unsigned*)(lds + 147392);
    if (tid < 2) bst[tid] = 0u;
    if (bx == 0) for (int i = tid; i < XCD_BAR_WORDS; i += 512) ((unsigned*)ws)[i] = 0u;
    __syncthreads();
    REPEAT(REP_PREP, prep_weights(a, ws, lds, 0, bx, G, tid, 0); prep_misc(a, ws, gw, NGW, gt, NT, lane); __syncthreads(););
    grid.sync();
    XcdBarrier bar = xcd_barrier_post((unsigned*)ws, bst);

    int cur = 0;
#pragma unroll 1
    for (int l = 0; l < 2; ++l) {
#pragma unroll 1
        for (int f = 0; f < 2; ++f) {
            const bf16* WGU = (const bf16*)(ws + (f ? WS_WGU2 : WS_WGU1)); const bf16* WD = (const bf16*)(ws + (f ? WS_WD2 : WS_WD1));
            { pg8::Gemm g{XB, WGU, 1024, 1024, 1024, T1K, 0, 0, T1K, 0, nullptr, 1 << 30}; pg8::EpiSwiGLU E{H, (bf16*)X, SSQ(cur)};
              GEMM(pg8::EpiSwiGLU, g, 192, 32, 1, bx, E);
#if REP_GU
              GEMM(pg8::EpiSwiGLU, g, 192, 32, 1, bx, E);
#endif
            }
            if (f == 0 && l == 1) REPEAT(REP_KV,
                { pg8::Gemm g{MEMB, WKV, 1024, 1024, 1024, T1K, 0, 0, T1K, 0, nullptr, 1 << 30}; pg8::EpiRowScale E{KB, 1024, (const float*)(ws + WS_SSQM)}; GEMM(pg8::EpiRowScale, g, 16, 4, 1, (bx + 64) % G, E); }
                { pg8::Gemm g{WKV + (size_t)1024 * 1024, MEMB, 1024, 1024, 1024, T1K, 0, 0, T1K, 0, nullptr, 1 << 30}; pg8::EpiVT E{VT, (const float*)(ws + WS_RSM)}; GEMM(pg8::EpiVT, g, 4, 16, 1, (bx + 128) % G, E); });
            if (f == 0 && l == 0) REPEAT(REP_TAB, s5_tab2(a, ws, gt, NT););
            if (l == 0 && f == 1) prep_weights(a, ws, lds, 1, bx, G, tid, 1);
            if (l == 1 && f == 0 && bx < G / 2) prep_weights(a, ws, lds, 1, bx, G / 2, tid, 3);
            XBAR();
            { pg8::Gemm g{H, WD, 4096, 4096, 4096, T1K * 4, 0, 0, T1K * 4, 0, (const bf16*)X, 128}; pg8::EpiRes E{XB, SSQ(cur ^ 1), 0.5f};
              GEMM(pg8::EpiRes, g, 192, 4, 1, bx, E);
#if REP_DOWN
              { pg8::EpiRes E2 = E; E2.alpha = 0.f; GEMM(pg8::EpiRes, g, 192, 4, 1, bx, E2); }
#endif
            }
            if (f == 0 && l == 0) REPEAT(REP_TAB, s5_tab3(a, ws, gt, NT););
            if (l == 0 && f == 1) prep_weights(a, ws, lds, 1, bx, G, tid, 2);
            XBAR();
            cur ^= 1;
            if (f == 0) {
                pg8::Gemm gm;
                if (l == 0) {
                    REPEAT(REP_WIN, { pg8::Gemm g{XB, (const bf16*)(ws + WS_WIN), 1024, 1024, 1024, T1K, 0, 0, T1K, 0, nullptr, 1 << 30}; pg8::EpiWin E{(bf16*)(ws + WS_AP), (bf16*)(ws + WS_ZUB), (bf16*)(ws + WS_ZVB), (pg8::f32x2*)(ws + WS_LNP), SSQ(cur)}; GEMM(pg8::EpiWin, g, 192, 6, 1, bx, E); });
                    REPEAT(REP_KV,
                        { pg8::Gemm g{MEMB, WKV, 1024, 1024, 1024, T1K, 0, 0, T1K, 0, nullptr, 1 << 30}; pg8::EpiRowScale E{KB, 1024, (const float*)(ws + WS_SSQM)}; GEMM(pg8::EpiRowScale, g, 16, 4, 1, (bx + 64) % G, E); }
                        { pg8::Gemm g{WKV + (size_t)1024 * 1024, MEMB, 1024, 1024, 1024, T1K, 0, 0, T1K, 0, nullptr, 1 << 30}; pg8::EpiVT E{VT, (const float*)(ws + WS_RSM)}; GEMM(pg8::EpiVT, g, 4, 16, 1, (bx + 128) % G, E); });
                    XBAR();
                    REPEAT(REP_S5, { pg8::Gemm g{(const bf16*)(ws + WS_AP), (const bf16*)(ws + WS_B1S), 768, 512, 512, (size_t)256 * 768 * 2, 0, (size_t)1536 * 768 * 2, 0, (size_t)256 * 512 * 2, nullptr, 1 << 30}; pg8::EpiS5aScan E{(float*)(ws + WS_SST), (bf16*)(ws + WS_AP), (const pg8::f32x2*)(ws + WS_APOW)}; GEMM_NA(pg8::EpiS5aScan, g, 6, 1, 32, bx, E); });
                    sgu_phase(lds, a, ws, 0, 640, (bx % 8) * (G / 8) + bx / 8, G, tid);
                    XBAR();
                    REPEAT(REP_S5, { pg8::Gemm g{(const bf16*)(ws + WS_AP), (const bf16*)(ws + WS_BT), 768, 768, 768, (size_t)256 * 768 * 2, 0, (size_t)1536 * 768 * 2, (size_t)256 * 768 * 2, (size_t)512 * 768 * 2, nullptr, 1 << 30}; pg8::EpiS5c E{(bf16*)(ws + WS_GB)}; GEMM(pg8::EpiS5c, g, 6, 2, 32, bx, E); });
                    sgu_phase(lds, a, ws, 640, 1152, bx >= G / 2 ? bx - G / 2 : -1, G / 2, tid);
                    XBAR();
                    REPEAT(REP_S5, { pg8::Gemm g{(const bf16*)(ws + WS_GB), (const bf16*)(ws + WS_WGLU), 512, 512, 512, (size_t)256 * 512 * 2, 0, 0, (size_t)256 * 512 * 2, 0, nullptr, 1 << 30}; pg8::EpiGLU E{(const bf16*)(ws + WS_GB), (bf16*)X}; GEMM(pg8::EpiGLU, g, 192, 2, 1, bx, E); });
                    sgu_phase(lds, a, ws, 1152, 1536, bx >= G / 2 ? bx - G / 2 : -1, G / 2, tid);
                    XBAR();
                    gm = pg8::Gemm{(const bf16*)X, (const bf16*)(ws + WS_WOUT), 1024, 1024, 1024, T1K, 0, 0, T1K, 0, nullptr, 1 << 30};
                } else {
                    REPEAT(REP_RES, pool_phase(lds, XB, SSQ(cur), (bf16*)(ws + WS_POOLED), G, bx, tid););
                    XBAR();
                    gm = pg8::Gemm{(const bf16*)(ws + WS_POOLED), (const bf16*)(ws + WS_WPOOL), 1024, 256, 256, T1K, (size_t)256 * 2, 0, (size_t)256 * 256 * 2, 0, nullptr, 1 << 30};
                }
                { pg8::EpiRes E{XB, SSQ(cur ^ 1), 1.0f}; GEMM(pg8::EpiRes, gm, 192, 4, 1, bx, E); if (REP_RES) { E.alpha = 0.f; GEMM(pg8::EpiRes, gm, 192, 4, 1, bx, E); } }
                XBAR();
                cur ^= 1;
                { pg8::Gemm g{XB, (const bf16*)(ws + WS_WQ), 1024, 1024, 1024, T1K, 0, 0, T1K, 0, nullptr, 1 << 30}; pg8::EpiRowScale E{QO, 1024, SSQ(cur)}; REPEAT(REP_Q, GEMM(pg8::EpiRowScale, g, 192, 4, 1, bx, E);); }
                XBAR();
                REPEAT(REP_A, attn_phase(lds, QO, (bf16*)(ws + WS_CAT), KB, VT, G, bx, tid););
                XBAR();
                { pg8::Gemm g{(const bf16*)(ws + WS_CAT), (const bf16*)(ws + WS_WO), 1024, 1024, 1024, T1K, 0, 0, T1K, 0, nullptr, 1 << 30}; pg8::EpiRes E{XB, SSQ(cur ^ 1), 1.0f}; GEMM(pg8::EpiRes, g, 192, 4, 1, bx, E); if (REP_RES) { E.alpha = 0.f; GEMM(pg8::EpiRes, g, 192, 4, 1, bx, E); } }
                XBAR();
                cur ^= 1;
            }
        }
    }
    final_phase(X, XB, SSQ(cur), a.in[35], gw, NGW, lane);
#ifdef REP_FINAL
    final_phase(X, XB, SSQ(cur), a.in[35], gw, NGW, lane);
#endif
}

extern "C" void kernel_launch(void* const* d_in, const int* in_sizes, int n_in, void* d_out, int out_size, void* d_ws, size_t ws_size, hipStream_t stream) {
    static int grid = 0;
    if (grid == 0) {
        if (n_in != 36 || out_size != M * D || ws_size < WS_END) { fprintf(stderr, "kernel_launch: unexpected shapes: n_in %d out %d ws %zu (need %zu)\n", n_in, out_size, ws_size, (size_t)WS_END); grid = -1; return; }
        int dev = 0, cus = 0, per_cu = 0;
        hipGetDevice(&dev);
        hipDeviceGetAttribute(&cus, hipDeviceAttributeMultiprocessorCount, dev);
        hipFuncSetAttribute((const void*)mk_fwd, hipFuncAttributeMaxDynamicSharedMemorySize, LDS_BYTES);
        hipOccupancyMaxActiveBlocksPerMultiprocessor(&per_cu, (const void*)mk_fwd, 512, LDS_BYTES);
        (void)hipGetLastError();
        grid = cus;
        if (grid % 8 != 0 || grid < 8) grid = (grid / 8) * 8;
        fprintf(stderr, "kernel_launch: grid %d (occupancy query: %d per CU), ws %zu\n", grid, per_cu, ws_size);
    }
    if (grid <= 0) return;
    Args a{};
    for (int i = 0; i < 36; ++i) a.in[i] = (const float*)d_in[i];
    a.out = (float*)d_out; a.ws = (unsigned char*)d_ws;
    void* args[] = {&a};
    hipError_t e = hipLaunchCooperativeKernel((const void*)mk_fwd, dim3(grid), dim3(512), args, LDS_BYTES, stream);
    if (e != hipSuccess) fprintf(stderr, "kernel_launch: cooperative launch failed: %s (grid %d)\n", hipGetErrorString(e), grid);
}
```
